# Optimizing an MI355X kernel written in HIP

```python
import jax, jax.numpy as jnp
from jax import lax
import numpy as np

D_MODEL = 1024
BATCH = 2
SEQ = 8192
DEPTH = 2

N_MEM = 256
D_MIX = D_MODEL
HGRN_DK = 128
HGRN_DV = 128
HGRN_WIDTH = D_MIX // 2
HGRN_HEADS = HGRN_WIDTH // HGRN_DV
HGRN_KW = HGRN_HEADS * HGRN_DK
FOX_DH = 64
FOX_WIDTH = D_MIX - HGRN_WIDTH
FOX_HEADS = FOX_WIDTH // FOX_DH
CHUNK = 64
Q_BLOCK = 128
D_FF = 2816
CROSS_HEADS = 4
CROSS_DH = D_MODEL // CROSS_HEADS
EPS = 1e-6
N_IN = 2 * HGRN_KW + 2 * HGRN_WIDTH + 3 * FOX_WIDTH + FOX_HEADS

kernel_name = "hymba_hgrn2_fox_macaron"


def rms_norm(x, w):
    x32 = x.astype(jnp.float32)
    y = x32 * lax.rsqrt(jnp.mean(x32 * x32, axis=-1, keepdims=True) + EPS)
    return (y * w.astype(jnp.float32)).astype(x.dtype)


def swiglu(h, w_gate, w_up, w_down):
    return (jax.nn.silu(h @ w_gate) * (h @ w_up)) @ w_down


def hgrn2_chunk_scan(q, k, v, logf):
    B, H, S, DK = q.shape
    DV = v.shape[-1]
    nc = S // CHUNK

    def to_chunks(t):
        return t.reshape(B, H, nc, CHUNK, t.shape[-1]).transpose(2, 0, 1, 3, 4)

    qc, kc, vc = to_chunks(q), to_chunks(k), to_chunks(v)
    gc = jnp.cumsum(to_chunks(logf), axis=-2)
    mask = jnp.tril(jnp.ones((CHUNK, CHUNK), dtype=bool))[None, None, :, :, None]

    def step(state, inp):
        q_, k_, v_, g_ = inp
        o_inter = jnp.einsum('bhtk,bhkv->bhtv', q_ * jnp.exp(g_), state)
        diff = g_[:, :, :, None, :] - g_[:, :, None, :, :]
        decay = jnp.exp(jnp.where(mask, diff, -jnp.inf))
        a = jnp.einsum('bhtk,bhsk,bhtsk->bhts', q_, k_, decay)
        o = o_inter + jnp.einsum('bhts,bhsv->bhtv', a, v_)
        g_last = g_[:, :, -1:, :]
        new_state = jnp.exp(g_last[:, :, 0, :])[..., None] * state + jnp.einsum(
            'bhsk,bhsv->bhkv', k_ * jnp.exp(g_last - g_), v_)
        return new_state, o

    s0 = jnp.zeros((B, H, DK, DV), jnp.float32)
    _, oc = lax.scan(step, s0, (qc, kc, vc, gc))
    return oc.transpose(1, 2, 0, 3, 4).reshape(B, H, S, DV)


def forgetting_attention(q, k, v, logf):
    B, H, S, dh = q.shape
    nb = S // Q_BLOCK
    c = jnp.cumsum(logf, axis=-1)
    qb = q.reshape(B, H, nb, Q_BLOCK, dh).transpose(2, 0, 1, 3, 4)
    cb = c.reshape(B, H, nb, Q_BLOCK).transpose(2, 0, 1, 3)
    kpos = jnp.arange(S)
    scale = dh ** -0.5

    def block(args):
        q_blk, c_blk, i = args
        s = jnp.einsum('bhqd,bhkd->bhqk', q_blk, k).astype(jnp.float32) * scale
        s = s + (c_blk[..., :, None] - c[:, :, None, :])
        qpos = i * Q_BLOCK + jnp.arange(Q_BLOCK)
        s = jnp.where(kpos[None, :] <= qpos[:, None], s, -jnp.inf)
        p = jax.nn.softmax(s, axis=-1)
        return jnp.einsum('bhqk,bhkd->bhqd', p.astype(v.dtype), v)

    ob = lax.map(block, (qb, cb, jnp.arange(nb)))
    return ob.transpose(1, 2, 0, 3, 4).reshape(B, H, S, dh)


def hybrid_mixer(h, w_in, lb, out_norm_w, fox_bf, w_out):
    B, S, _ = h.shape
    sizes = [HGRN_KW, HGRN_KW, HGRN_WIDTH, HGRN_WIDTH, FOX_WIDTH, FOX_WIDTH, FOX_WIDTH]
    offsets = [int(o) for o in np.cumsum(sizes)]
    z = h @ w_in
    hq, hf, hi, hg, fq, fk, fv, ff = jnp.split(z, offsets, axis=-1)

    def heads(t, n):
        return t.reshape(B, S, n, -1).transpose(0, 2, 1, 3)

    zf = hf.astype(jnp.float32)
    lb32 = lb.astype(jnp.float32)
    logf_h = jnp.logaddexp(jnp.log(lb32), jnp.log1p(-lb32) + jax.nn.log_sigmoid(zf))
    k_h = (1.0 - lb32) * jax.nn.sigmoid(-zf)
    q_h = jax.nn.silu(hq.astype(jnp.float32))
    o_h = hgrn2_chunk_scan(heads(q_h, HGRN_HEADS), heads(k_h, HGRN_HEADS),
                           heads(hi.astype(jnp.float32), HGRN_HEADS),
                           heads(logf_h, HGRN_HEADS))
    o_h = rms_norm(o_h.transpose(0, 2, 1, 3), out_norm_w).reshape(B, S, HGRN_WIDTH)
    o_h = o_h * jax.nn.silu(hg.astype(jnp.float32))

    logf_f = jax.nn.log_sigmoid(ff.astype(jnp.float32) + fox_bf.astype(jnp.float32))
    o_f = forgetting_attention(heads(fq, FOX_HEADS), heads(fk, FOX_HEADS),
                               heads(fv, FOX_HEADS), logf_f.transpose(0, 2, 1))
    o_f = o_f.transpose(0, 2, 1, 3).reshape(B, S, FOX_WIDTH)

    o = jnp.concatenate([o_h.astype(h.dtype), o_f.astype(h.dtype)], axis=-1)
    return o @ w_out


def memory_cross_attention(h, m, wq, wk, wv, wo):
    B, S, _ = h.shape
    M = m.shape[1]
    q = (h @ wq).reshape(B, S, CROSS_HEADS, CROSS_DH)
    k = (m @ wk).reshape(B, M, CROSS_HEADS, CROSS_DH)
    v = (m @ wv).reshape(B, M, CROSS_HEADS, CROSS_DH)
    s = jnp.einsum('bshd,bmhd->bhsm', q, k).astype(jnp.float32) * (CROSS_DH ** -0.5)
    p = jax.nn.softmax(s, axis=-1).astype(h.dtype)
    o = jnp.einsum('bhsm,bmhd->bshd', p, v).reshape(B, S, D_MODEL)
    return o @ wo


def setup_inputs(seed: int = 0) -> dict:
    key = jax.random.key(seed)
    ks = jax.random.split(key, 24)
    n = jax.random.normal
    f32 = jnp.float32

    def w(k, shape, fan_in):
        return n(k, shape, f32) * fan_in ** -0.5

    def gain(k, shape):
        return 1.0 + 0.05 * n(k, shape, f32)

    return {
        "x": n(ks[0], (BATCH, SEQ, D_MODEL), f32),
        "mem": n(ks[1], (BATCH, N_MEM, D_MODEL), f32),
        "ffn1_norm": gain(ks[2], (DEPTH, D_MODEL)),
        "ffn1_w_gate": w(ks[3], (DEPTH, D_MODEL, D_FF), D_MODEL),
        "ffn1_w_up": w(ks[4], (DEPTH, D_MODEL, D_FF), D_MODEL),
        "ffn1_w_down": w(ks[5], (DEPTH, D_FF, D_MODEL), D_FF),
        "mix_norm": gain(ks[6], (DEPTH, D_MODEL)),
        "w_in": w(ks[7], (DEPTH, D_MODEL, N_IN), D_MODEL),
        "hgrn_lb": n(ks[8], (DEPTH, HGRN_KW), f32),
        "hgrn_out_norm": gain(ks[9], (DEPTH, HGRN_DV)),
        "fox_f_bias": 2.0 + 0.5 * n(ks[10], (DEPTH, FOX_HEADS), f32),
        "w_out": w(ks[11], (DEPTH, D_MIX, D_MODEL), D_MIX),
        "cross_norm": gain(ks[12], (DEPTH, D_MODEL)),
        "mem_norm": gain(ks[13], (DEPTH, D_MODEL)),
        "cross_wq": w(ks[14], (DEPTH, D_MODEL, D_MODEL), D_MODEL),
        "cross_wk": w(ks[15], (DEPTH, D_MODEL, D_MODEL), D_MODEL),
        "cross_wv": w(ks[16], (DEPTH, D_MODEL, D_MODEL), D_MODEL),
        "cross_wo": w(ks[17], (DEPTH, D_MODEL, D_MODEL), D_MODEL),
        "ffn2_norm": gain(ks[18], (DEPTH, D_MODEL)),
        "ffn2_w_gate": w(ks[19], (DEPTH, D_MODEL, D_FF), D_MODEL),
        "ffn2_w_up": w(ks[20], (DEPTH, D_MODEL, D_FF), D_MODEL),
        "ffn2_w_down": w(ks[21], (DEPTH, D_FF, D_MODEL), D_FF),
        "final_norm": gain(ks[22], (D_MODEL,)),
    }


def reference(x, mem, ffn1_norm, ffn1_w_gate, ffn1_w_up, ffn1_w_down, mix_norm, w_in,
              hgrn_lb, hgrn_out_norm, fox_f_bias, w_out, cross_norm, mem_norm,
              cross_wq, cross_wk, cross_wv, cross_wo, ffn2_norm, ffn2_w_gate,
              ffn2_w_up, ffn2_w_down, final_norm):
    lb_cum = jnp.cumsum(jax.nn.softmax(hgrn_lb.astype(jnp.float32), axis=0), axis=0)
    lb_all = lb_cum - lb_cum[0:1]
    for l in range(DEPTH):
        x = x + 0.5 * swiglu(rms_norm(x, ffn1_norm[l]), ffn1_w_gate[l], ffn1_w_up[l], ffn1_w_down[l])
        x = x + hybrid_mixer(rms_norm(x, mix_norm[l]), w_in[l], lb_all[l], hgrn_out_norm[l],
                             fox_f_bias[l], w_out[l])
        x = x + memory_cross_attention(rms_norm(x, cross_norm[l]), rms_norm(mem, mem_norm[l]),
                                       cross_wq[l], cross_wk[l], cross_wv[l], cross_wo[l])
        x = x + 0.5 * swiglu(rms_norm(x, ffn2_norm[l]), ffn2_w_gate[l], ffn2_w_up[l], ffn2_w_down[l])
    return rms_norm(x, final_norm)
```

```cpp
#include <hip/hip_runtime.h>
#include <hip/hip_cooperative_groups.h>
#include <cstdio>
#include <cstdint>
namespace cg = cooperative_groups;
namespace pg8 {
#define PG8_LAS __attribute__((address_space(3)))
typedef unsigned short bf16_t;
typedef short bf16x8 __attribute__((ext_vector_type(8)));
typedef float f32x4 __attribute__((ext_vector_type(4)));
typedef unsigned u32x4 __attribute__((ext_vector_type(4)));
constexpr int BM = 256, BK = 64, HALF = 128, HTB = HALF * BK * 2  , STAGE_BYTES = 8 * HTB, NXCD = 8, WGM = 8;

__host__ __device__ __forceinline__ int lds_byte(int r, int c) { const int st = (r >> 4) * 2 + (c >> 5), rr = r & 15, cc = c & 31, ob = rr * 64 + cc * 2; return st * 1024 + (ob ^ (((ob >> 9) & 1) << 5)); }
__host__ __device__ __forceinline__ void stage_rc(int b, int& R, int& C) { const int st = b / 1024, sb = b % 1024, swz = sb ^ (((sb >> 9) & 1) << 5); R = (st >> 1) * 16 + swz / 64; C = (st & 1) * 32 + (swz % 64) / 2; }
__host__ __device__ __forceinline__ int perm32(int rho) { const int n = rho >> 4, i = rho & 15; return 8 * (i >> 2) + 4 * n + (i & 3); }

struct Unit { int pm, pn; };
struct Gemm { const bf16_t* A; const bf16_t* Bt; int M, N, K, lda, ldb; };

struct StaticOrder {
    int nM, nN, nwg, G, c;
    __host__ __device__ void init(int M, int N, int G_, int c_) { nM = M / BM; nN = N / BM; nwg = nM * nN; G = G_; c = c_; }
    __host__ __device__ bool next(int i, Unit& u) const {
        const long L = (long)i * G + c; if (L >= nwg) return false;
        int wgid = (int)L; { const int q = nwg / NXCD, r = nwg % NXCD, xcd = wgid % NXCD, off = wgid / NXCD; wgid = (xcd < r ? xcd * (q + 1) : r * (q + 1) + (xcd - r) * q) + off; }
        const int nig = WGM * nN, gid = wgid / nig, fm = gid * WGM, gsz = (nM - fm) < WGM ? (nM - fm) : WGM;
        u.pm = fm + ((wgid % nig) % gsz); u.pn = (wgid % nig) / gsz; return true;
    }
    __device__ __forceinline__ void a_ready(const Unit&) const {}
    __device__ __forceinline__ void done(const Unit&) const {}
    __device__ __forceinline__ size_t aoff(const Unit& u, size_t tstep) const { return (size_t)u.pm * tstep; }
    __device__ __forceinline__ size_t boff(const Unit& u, size_t tstep) const { return (size_t)u.pn * tstep; }
};
struct BatchOrder : StaticOrder { int mb; size_t bstride;
    __device__ __forceinline__ size_t boff(const Unit& u, size_t tstep) const { return (size_t)u.pn * tstep + (u.pm >= mb ? bstride : 0); } };
struct FoldOrder { int j; bool modeB;
    __device__ __forceinline__ bool next(int i, Unit& u) const { if (i > 0 || j < 0 || j >= 32) return false; u.pm = j; u.pn = 0; return true; }
    __device__ __forceinline__ void a_ready(const Unit&) const {}
    __device__ __forceinline__ void done(const Unit&) const {}
    __device__ __forceinline__ size_t aoff(const Unit& u, size_t) const { const int hd = u.pm >> 3, b = (u.pm >> 2) & 1, q = u.pm & 3; return modeB ? ((size_t)q * 256 * 1024 + hd * 256) * 2 : ((size_t)b * 256 * 2048 + hd * 256) * 2; }
    __device__ __forceinline__ size_t boff(const Unit& u, size_t) const { const int hd = u.pm >> 3, b = (u.pm >> 2) & 1, q = u.pm & 3; return modeB ? ((size_t)b * 256 * 2048 + 1024 + hd * 256) * 2 : ((size_t)q * 256 * 1024 + hd * 256) * 2; }
};

typedef float f32x2cv __attribute__((ext_vector_type(2))); typedef __bf16 bf16x2cv __attribute__((ext_vector_type(2)));
__device__ __forceinline__ unsigned cvt_pk_bf16(float lo, float hi) { const f32x2cv v = {lo, hi}; const bf16x2cv b = __builtin_convertvector(v, bf16x2cv); return __builtin_bit_cast(unsigned, b); }
template <class Epi, class Sched, bool ALIGN_EPI = false, bool SP2 = false>
__device__ __forceinline__ void gemm_phase(PG8_LAS unsigned char* lds, const Gemm g, const Sched& S, const Epi& E) {
    int tid_ = threadIdx.x; asm volatile("" : "+v"(tid_)); const int tid = tid_, wid = __builtin_amdgcn_readfirstlane(tid >> 6), lane = tid & 63, wr = wid >> 2, wc = wid & 3, fr = lane & 15, fq = lane >> 4;
    const int K = g.K, nt = K / BK;
    unsigned voffA[2], voffB[2];
#pragma unroll
    for (int i = 0; i < 2; ++i) { int R, C; stage_rc(tid * 16 + i * 8192, R, C); const int Rb = Epi::PERM ? ((R & ~31) + perm32(R & 31)) : R;
        voffA[i] = (unsigned)(R * g.lda + C) * 2u; voffB[i] = (unsigned)(Rb * g.ldb + C) * 2u; }
    const size_t kstep = (size_t)(BK * 2);
    const size_t hstepA = (size_t)HALF * g.lda * 2, hstepB = (size_t)HALF * g.ldb * 2;
    const size_t tstepA = 2 * hstepA, tstepB = 2 * hstepB;
    const unsigned ldsw = (unsigned)wid * 1024u;
    const int aoff = lds_byte(wr * 64 + fr, fq * 8), boff = lds_byte(wc * 32 + fr, fq * 8);
#define PG8_SA(b, h) (((b) * 2 + (h)) * HTB)
#define PG8_SB(b, h) ((4 + (b) * 2 + (h)) * HTB)
#define PG8_STAGE(bufoff, gbase, voff) do { _Pragma("unroll") for (int _i = 0; _i < 2; ++_i) \
        __builtin_amdgcn_global_load_lds((const unsigned*)((const char*)(gbase) + (voff)[_i]), (PG8_LAS unsigned*)(lds + (bufoff) + ldsw + _i * 8192), 16, 0, 0); } while (0)
#define PG8_LDA(dst, b, h) do { _Pragma("unroll") for (int m = 0; m < 4; ++m) _Pragma("unroll") for (int k = 0; k < 2; ++k) dst[m][k] = *(const PG8_LAS bf16x8*)(lds + PG8_SA(b, h) + aoff + m * 2048 + k * 1024); } while (0)
#define PG8_LDB(dst, b, h) do { _Pragma("unroll") for (int n = 0; n < 2; ++n) _Pragma("unroll") for (int k = 0; k < 2; ++k) dst[n][k] = *(const PG8_LAS bf16x8*)(lds + PG8_SB(b, h) + boff + n * 2048 + k * 1024); } while (0)
#define PG8_MMA(ai, bj, At, Bt) do { __builtin_amdgcn_s_setprio(1); _Pragma("unroll") for (int m = 0; m < 4; ++m) _Pragma("unroll") for (int n = 0; n < 2; ++n) _Pragma("unroll") for (int k = 0; k < 2; ++k) \
        acc[ai][bj][m][n] = __builtin_amdgcn_mfma_f32_16x16x32_bf16(Bt[n][k], At[m][k], acc[ai][bj][m][n], 0, 0, 0); __builtin_amdgcn_s_setprio(0); } while (0)
#define PG8_WAIT_V(n) asm volatile("s_waitcnt vmcnt(" #n ")" ::: "memory")
#define PG8_WAIT_L(n) asm volatile("s_waitcnt lgkmcnt(" #n ")" ::: "memory")
#define PG8_BAR __builtin_amdgcn_s_barrier()
#define PG8_SCHED __builtin_amdgcn_sched_barrier(0)
    Unit cur, nxt; int ui = 0;
    if (!S.next(0, cur)) return;
    f32x4 acc[2][2][4][2];
#pragma unroll
    for (int a = 0; a < 2; ++a)
#pragma unroll
        for (int b = 0; b < 2; ++b)
#pragma unroll
            for (int m = 0; m < 4; ++m)
#pragma unroll
                for (int n = 0; n < 2; ++n) acc[a][b][m][n] = (f32x4){0.f, 0.f, 0.f, 0.f};
    bf16x8 At[4][2], B0[2][2], B1[2][2];
    const char* cA = (const char*)g.A + S.aoff(cur, tstepA); const char* cB = (const char*)g.Bt + S.boff(cur, tstepB);
    S.a_ready(cur);
    if constexpr (SP2) {
        PG8_STAGE(PG8_SB(0, 0), cB, voffB); PG8_STAGE(PG8_SB(0, 1), cB + hstepB, voffB); PG8_STAGE(PG8_SA(0, 0), cA, voffA); PG8_STAGE(PG8_SA(0, 1), cA + hstepA, voffA);
        if (wr == 1) PG8_BAR;
        PG8_WAIT_V(2); PG8_BAR;
        PG8_STAGE(PG8_SB(1, 0), cB + kstep, voffB); PG8_STAGE(PG8_SA(1, 0), cA + kstep, voffA); PG8_STAGE(PG8_SB(1, 1), cB + hstepB + kstep, voffB);
        PG8_WAIT_V(6); PG8_BAR;
    } else {
        PG8_STAGE(PG8_SB(0, 0), cB, voffB); PG8_STAGE(PG8_SA(0, 0), cA, voffA); PG8_STAGE(PG8_SB(0, 1), cB + hstepB, voffB); PG8_STAGE(PG8_SA(0, 1), cA + hstepA, voffA);
        if (wr == 1) PG8_BAR;
        PG8_WAIT_V(4); PG8_BAR;
        PG8_STAGE(PG8_SB(1, 0), cB + kstep, voffB); PG8_STAGE(PG8_SA(1, 0), cA + kstep, voffA); PG8_STAGE(PG8_SB(1, 1), cB + hstepB + kstep, voffB);
        PG8_WAIT_V(6); PG8_BAR;
    }
    for (;;) {
        const bool has_next = S.next(ui + 1, nxt);
        const char* nA = has_next ? (const char*)g.A + S.aoff(nxt, tstepA) : cA; const char* nB = has_next ? (const char*)g.Bt + S.boff(nxt, tstepB) : cB;
        for (int t = 0; t < nt; t += 2) {
            const bool last = (t == nt - 2);
            const char* a1 = cA + (size_t)(t + 1) * kstep;
            const char* a2 = last ? nA : cA + (size_t)(t + 2) * kstep; const char* b2 = last ? nB : cB + (size_t)(t + 2) * kstep;
            const char* a3 = a2 + kstep; const char* b3 = b2 + kstep;
            if (last && has_next) S.a_ready(nxt);
            if constexpr (SP2) {
            PG8_LDB(B0, 0, 0); PG8_LDB(B1, 0, 1); PG8_SCHED; PG8_LDA(At, 0, 0); PG8_STAGE(PG8_SA(1, 1), a1 + hstepA, voffA);
            PG8_WAIT_V(8); PG8_WAIT_L(0); PG8_BAR; PG8_MMA(0, 0, At, B0); PG8_MMA(0, 1, At, B1); PG8_BAR; PG8_SCHED;
            PG8_LDA(At, 0, 1); PG8_STAGE(PG8_SB(0, 0), b2, voffB); PG8_STAGE(PG8_SB(0, 1), b2 + hstepB, voffB); PG8_STAGE(PG8_SA(0, 0), a2, voffA);
            PG8_WAIT_V(8); PG8_WAIT_L(0); PG8_BAR; PG8_MMA(1, 0, At, B0); PG8_MMA(1, 1, At, B1); PG8_BAR; PG8_SCHED;
            PG8_LDB(B0, 1, 0); PG8_LDB(B1, 1, 1); PG8_SCHED; PG8_LDA(At, 1, 0); PG8_STAGE(PG8_SA(0, 1), a2 + hstepA, voffA);
            PG8_WAIT_V(8); PG8_WAIT_L(0); PG8_BAR; PG8_MMA(0, 0, At, B0); PG8_MMA(0, 1, At, B1); PG8_BAR; PG8_SCHED;
            PG8_LDA(At, 1, 1); PG8_STAGE(PG8_SB(1, 0), b3, voffB); PG8_STAGE(PG8_SB(1, 1), b3 + hstepB, voffB); PG8_STAGE(PG8_SA(1, 0), a3, voffA);
            PG8_WAIT_V(8); PG8_WAIT_L(0); PG8_BAR; PG8_MMA(1, 0, At, B0); PG8_MMA(1, 1, At, B1); PG8_BAR; PG8_SCHED;
            } else {
            PG8_LDB(B0, 0, 0); PG8_SCHED; PG8_LDA(At, 0, 0); PG8_STAGE(PG8_SA(1, 1), a1 + hstepA, voffA);
            PG8_WAIT_L(8); PG8_BAR; PG8_WAIT_L(0); PG8_MMA(0, 0, At, B0); PG8_BAR; PG8_SCHED;
            PG8_LDB(B1, 0, 1); PG8_STAGE(PG8_SB(0, 0), b2, voffB);
            PG8_BAR; PG8_WAIT_L(0); PG8_MMA(0, 1, At, B1); PG8_BAR;
            PG8_LDA(At, 0, 1); PG8_STAGE(PG8_SA(0, 0), a2, voffA);
            PG8_BAR; PG8_WAIT_L(0); PG8_MMA(1, 0, At, B0); PG8_BAR; PG8_SCHED;
            PG8_STAGE(PG8_SB(0, 1), b2 + hstepB, voffB);
            PG8_WAIT_V(6); PG8_BAR; PG8_MMA(1, 1, At, B1); PG8_BAR;
            PG8_LDB(B0, 1, 0); PG8_SCHED; PG8_LDA(At, 1, 0); PG8_STAGE(PG8_SA(0, 1), a2 + hstepA, voffA);
            PG8_WAIT_L(8); PG8_BAR; PG8_WAIT_L(0); PG8_MMA(0, 0, At, B0); PG8_BAR; PG8_SCHED;
            PG8_LDB(B1, 1, 1); PG8_STAGE(PG8_SB(1, 0), b3, voffB);
            PG8_BAR; PG8_WAIT_L(0); PG8_MMA(0, 1, At, B1); PG8_BAR;
            PG8_LDA(At, 1, 1); PG8_STAGE(PG8_SA(1, 0), a3, voffA);
            PG8_BAR; PG8_WAIT_L(0); PG8_MMA(1, 0, At, B0); PG8_BAR; PG8_SCHED;
            PG8_STAGE(PG8_SB(1, 1), b3 + hstepB, voffB);
            PG8_WAIT_V(6); PG8_BAR; PG8_MMA(1, 1, At, B1); PG8_BAR;
            }
        }
        if constexpr (ALIGN_EPI) { if (wr == 0) PG8_BAR; }
        if constexpr (!Epi::AFTER_DRAIN) { E(acc, cur, wr, wc, fr, fq); S.done(cur); }
        if (!has_next) break;
#pragma unroll
        for (int a = 0; a < 2; ++a)
#pragma unroll
            for (int b = 0; b < 2; ++b)
#pragma unroll
                for (int m = 0; m < 4; ++m)
#pragma unroll
                    for (int n = 0; n < 2; ++n) acc[a][b][m][n] = (f32x4){0.f, 0.f, 0.f, 0.f};
        cur = nxt; cA = nA; cB = nB; ++ui;
        if constexpr (ALIGN_EPI) { if (wr == 1) PG8_BAR; }
    }
    PG8_WAIT_V(0);
    if constexpr (!ALIGN_EPI) { if (wr == 0) PG8_BAR; }
    PG8_BAR;
    if constexpr (Epi::AFTER_DRAIN) { E.fused(acc, cur, wr, wc, fr, fq, lds, wid, lane); S.done(cur); }
#undef PG8_SA
#undef PG8_SB
#undef PG8_STAGE
#undef PG8_LDA
#undef PG8_LDB
#undef PG8_MMA
#undef PG8_WAIT_V
#undef PG8_WAIT_L
#undef PG8_BAR
#undef PG8_SCHED
}
}
#include <hip/hip_bf16.h>
namespace attn_body {
using bf16=__hip_bfloat16;
using bf16x8=__attribute__((ext_vector_type(8)))short;
using s16x4=__attribute__((ext_vector_type(4)))short;
using f32x16=__attribute__((ext_vector_type(16)))float;
using u32x4=__attribute__((ext_vector_type(4)))unsigned;
constexpr int BATCH=2,NHEAD=8,SEQ=8192,D=64,QP=1024,KP=512;
constexpr int NW=8,QBLK=32,QB=QBLK*NW,KVBLK=64,NQB=SEQ/QB;
constexpr int ATTN_UNIT_ROWS=QB;
__device__ __forceinline__ int crow(int r,int hi){return (r&3)+8*(r>>2)+4*hi;}
#define SBAR() __builtin_amdgcn_sched_barrier(0)
__device__ __forceinline__ void cmask(f32x16&p0,f32x16&p1,int jb,int qrel,int hi){
  const float NEG=-INFINITY; int kb=64*jb+4*hi;
  #pragma unroll
  for(int r=0;r<16;++r){int kv=kb+(r&3)+8*(r>>2); if(kv>qrel)p0[r]=NEG; if(kv+32>qrel)p1[r]=NEG;}
}

constexpr int NSLOT=3, SLOTB=8192;
constexpr int LDS_K=0, LDS_V=NSLOT*SLOTB, LDS_WS=2*NSLOT*SLOTB, LDS_OST=LDS_WS+NW*64*4, LDS_CK=LDS_OST+NW*4096, LDS_BYTES=LDS_CK+SEQ*4;
constexpr float C2=0.125f*1.4426950408889634f;
__device__ __forceinline__ void glds16(const void*gsrc,unsigned lds_dst){unsigned keep;
  asm volatile("s_mov_b32 %0, m0\n\ts_mov_b32 m0, %2\n\ts_nop 0\n\tglobal_load_lds_dwordx4 %1, off\n\ts_mov_b32 m0, %0":"=&s"(keep):"v"(gsrc),"s"(lds_dst):"memory");}
__device__ __forceinline__ float max3f(float a,float b,float c){float r;asm("v_max3_f32 %0, %1, %2, %3":"=v"(r):"v"(a),"v"(b),"v"(c));return r;}
__device__ __forceinline__ float max2f(float a,float b){float r;asm("v_max_f32_e32 %0, %1, %2":"=v"(r):"v"(a),"v"(b));return r;}
__device__ __forceinline__ float fadd_s(float a,float b){float r;asm("v_add_f32_e32 %0, %1, %2":"=v"(r):"v"(a),"v"(b));return r;}
__device__ __forceinline__ float fsub_s(float a,float b){float r;asm("v_sub_f32_e32 %0, %1, %2":"=v"(r):"v"(a),"v"(b));return r;}
typedef float f32x2_t __attribute__((ext_vector_type(2))); typedef __bf16 bf16x2_t __attribute__((ext_vector_type(2)));
__device__ __forceinline__ unsigned cvtpk_s(float lo,float hi){f32x2_t v={lo,hi};bf16x2_t b=__builtin_convertvector(v,bf16x2_t);return __builtin_bit_cast(unsigned,b);}
#define WAIT_BAR(N) asm volatile("s_waitcnt vmcnt(" #N ") lgkmcnt(0)\n\ts_barrier":::"memory")

__device__ __forceinline__ void qkt(f32x16&p0,f32x16&p1,const char*Kslot,const bf16x8*qr,const f32x16&negm,int r32,int hi){
  const char*kb=Kslot+hi*1024+r32*16;
  #pragma unroll
  for(int d0=0;d0<4;++d0){
    const bf16x8 b0=*reinterpret_cast<const bf16x8*>(kb+d0*2048);
    const bf16x8 b1=*reinterpret_cast<const bf16x8*>(kb+d0*2048+512);
    if(d0==0){p0=__builtin_amdgcn_mfma_f32_32x32x16_bf16(b0,qr[0],negm,0,0,0);p1=__builtin_amdgcn_mfma_f32_32x32x16_bf16(b1,qr[0],negm,0,0,0);}
    else{p0=__builtin_amdgcn_mfma_f32_32x32x16_bf16(b0,qr[d0],p0,0,0,0);p1=__builtin_amdgcn_mfma_f32_32x32x16_bf16(b1,qr[d0],p1,0,0,0);}}
}
typedef __attribute__((address_space(3))) const char* lds_cptr;
typedef short v4i16_t __attribute__((ext_vector_type(4)));
__device__ __forceinline__ void kload8(bf16x8*kf,lds_cptr kp){
  kf[0]=*(const __attribute__((address_space(3))) bf16x8*)(kp);      kf[1]=*(const __attribute__((address_space(3))) bf16x8*)(kp+512);
  kf[2]=*(const __attribute__((address_space(3))) bf16x8*)(kp+2048); kf[3]=*(const __attribute__((address_space(3))) bf16x8*)(kp+2560);
  kf[4]=*(const __attribute__((address_space(3))) bf16x8*)(kp+4096); kf[5]=*(const __attribute__((address_space(3))) bf16x8*)(kp+4608);
  kf[6]=*(const __attribute__((address_space(3))) bf16x8*)(kp+6144); kf[7]=*(const __attribute__((address_space(3))) bf16x8*)(kp+6656);
}
__device__ __forceinline__ void kload2(bf16x8*kf,lds_cptr kp,int j){ kf[2*j]=*(const __attribute__((address_space(3))) bf16x8*)(kp+j*2048); kf[2*j+1]=*(const __attribute__((address_space(3))) bf16x8*)(kp+j*2048+512); }
__device__ __forceinline__ s16x4 vtr(lds_cptr p){ return __builtin_bit_cast(s16x4,__builtin_amdgcn_ds_read_tr16_b64_v4i16((__attribute__((address_space(3))) v4i16_t*)p)); }
__device__ __forceinline__ float rowmax(const f32x16&p0,const f32x16&p1){
  float a=max3f(p0[0],p0[1],p1[0]),b=max3f(p0[2],p0[3],p1[1]);a=max3f(a,p1[2],p1[3]);
  #pragma unroll
  for(int r=4;r<16;r+=4){a=max3f(a,p0[r],p0[r+1]);b=max3f(b,p0[r+2],p0[r+3]);a=max3f(a,p1[r],p1[r+1]);b=max3f(b,p1[r+2],p1[r+3]);}
  const float m=max2f(a,b);
  auto rr=__builtin_amdgcn_permlane32_swap(__float_as_uint(m),__float_as_uint(m),false,false);
  return max2f(__uint_as_float(rr[0]),__uint_as_float(rr[1]));
}
__device__ __forceinline__ void pv(f32x16*o,int vb,bf16x8 pa0,bf16x8 pa1,bf16x8 pa2,bf16x8 pa3){
  #pragma unroll
  for(int d0=0;d0<2;++d0){s16x4 lo[4],hi[4];
    #pragma unroll
    for(int ks=0;ks<4;++ks){
      asm volatile("ds_read_b64_tr_b16 %0,%1 offset:%c2":"=&v"(lo[ks]):"v"(vb),"i"(d0*4096+ks*1024):"memory");
      asm volatile("ds_read_b64_tr_b16 %0,%1 offset:%c2":"=&v"(hi[ks]):"v"(vb),"i"(d0*4096+ks*1024+512):"memory");}
    asm volatile("s_waitcnt lgkmcnt(0)":::"memory");SBAR();
    #define PK(k) (bf16x8){lo[k][0],lo[k][1],lo[k][2],lo[k][3],hi[k][0],hi[k][1],hi[k][2],hi[k][3]}
    o[d0]=__builtin_amdgcn_mfma_f32_32x32x16_bf16(pa0,PK(0),o[d0],0,0,0);
    o[d0]=__builtin_amdgcn_mfma_f32_32x32x16_bf16(pa1,PK(1),o[d0],0,0,0);
    o[d0]=__builtin_amdgcn_mfma_f32_32x32x16_bf16(pa2,PK(2),o[d0],0,0,0);
    o[d0]=__builtin_amdgcn_mfma_f32_32x32x16_bf16(pa3,PK(3),o[d0],0,0,0);
    #undef PK
  }
}

#ifndef ATTN_STORE16
#define ATTN_STORE16(p,v) (*(u32x4*)(p)=(v))
#endif
template<int THRL> __device__ __forceinline__ void attn_unit(int b,int h,int qb,const bf16*Q,const bf16*__restrict__ K,const bf16*__restrict__ V,bf16*O,const float*__restrict__ CK,const float*__restrict__ KMX,const float*__restrict__ QSV,char*shm){
  int tid_=threadIdx.x; asm volatile("":"+v"(tid_)); const int tid=tid_,lane=tid&63,r32=lane&31,hi=lane>>5; const int wid=__builtin_amdgcn_readfirstlane(tid>>6);
  const long rowbase=(long)b*SEQ; const int q0=qb*QB;
  int ts;
  { const int NT0=(q0+QB)/KVBLK; const float qmx=QSV[0],smn=QSV[1];
    bool ns0=true,ns1=true;
    if(lane<NT0){ const float bd=qmx*KMX[lane]-CK[64*lane+63]-smn; ns0=!(bd<-40.f); }
    if(lane+64<NT0){ const float bd=qmx*KMX[lane+64]-CK[64*(lane+64)+63]-smn; ns1=!(bd<-40.f); }
    const unsigned long long m0=__ballot(ns0),m1=__ballot(ns1);
    int first=m0?__builtin_ctzll(m0):(m1?64+__builtin_ctzll(m1):128);
    first=first<NT0-4?first:NT0-4; ts=__builtin_amdgcn_readfirstlane(first&~1); }
  CK+=ts*KVBLK;
  const bf16*Qw=Q+(rowbase+q0+wid*QBLK)*QP+h*D;
  const bf16*Kh=K+(rowbase+(long)ts*KVBLK)*KP+h*D,*Vh=V+(rowbase+(long)ts*KVBLK)*KP+h*D;
  const unsigned lds0=(unsigned)(uintptr_t)shm;
  typedef __attribute__((address_space(3))) const float* lds_fptr; typedef float f32x4v __attribute__((ext_vector_type(4))); const __attribute__((address_space(3))) char* shm3f=(const __attribute__((address_space(3))) char*)shm;
  float*wsf=(float*)(shm+LDS_WS)+wid*64;
  const bf16*ksrc=Kh+(long)lane*KP+wid*8;
  const bf16*vsrc=Vh+(long)(16*(wid&3)+(lane>>2))*KP+(wid>>2)*32+(lane&3)*8;
  const unsigned kdst=lds0+LDS_K+wid*1024, vdst=lds0+LDS_V+wid*1024;
  #define DMA_K(t,slot) glds16(ksrc+(long)(t)*KVBLK*KP,(unsigned)__builtin_amdgcn_readfirstlane(kdst+(slot)))
  #define DMA_V(t,slot) glds16(vsrc+(long)(t)*KVBLK*KP,(unsigned)__builtin_amdgcn_readfirstlane(vdst+(slot)))
  const int vb0=(int)(lds0+LDS_V)+((lane>>4)&1)*32+(lane&3)*8+(4*hi+((lane&15)>>2))*64;
  const char*Kbase=shm+LDS_K; bf16x8 kf[8];
  const lds_cptr shm3=(lds_cptr)shm; const lds_cptr kp0=shm3+LDS_K+hi*1024+r32*16; const lds_cptr vp0=shm3+LDS_V+((lane>>4)&1)*32+(lane&3)*8+(4*hi+((lane&15)>>2))*64;
  const int NT=(q0+QB)/KVBLK-ts;
  { float*ckw=(float*)(shm+LDS_CK); const int nk4=NT*(KVBLK/4);
    for(int i=tid;i<nk4;i+=NW*64){ const f32x4v c4=*reinterpret_cast<const f32x4v*>(CK+4*i); *reinterpret_cast<f32x4v*>(ckw+4*i)=c4; } }
  const lds_fptr ckl=(lds_fptr)(shm3f+LDS_CK)+4*hi;
  #define LDC(p) (*(const __attribute__((address_space(3))) f32x4v*)(p))
  #define KBIAS(P0,P1,t) do{ _Pragma("unroll") for(int g_=0;g_<4;++g_){ const f32x4v c0_=*(const __attribute__((address_space(3))) f32x4v*)(ckl+(t)*64+8*g_), c1_=*(const __attribute__((address_space(3))) f32x4v*)(ckl+(t)*64+32+8*g_); \
      _Pragma("unroll") for(int i_=0;i_<4;++i_){ P0[4*g_+i_]-=c0_[i_]; P1[4*g_+i_]-=c1_[i_]; } } }while(0)
  DMA_K(0,0);DMA_V(0,0);DMA_K(1,SLOTB);
  bf16x8 qr[4];
  #pragma unroll
  for(int d0=0;d0<4;++d0)qr[d0]=*reinterpret_cast<const bf16x8*>(&Qw[(long)r32*QP+d0*16+hi*8]);
  float mhat=0.f,l_reg=0.f;f32x16 o[2];o[0]=f32x16{};o[1]=f32x16{};const f32x16 zero16=f32x16{};
  const int qrel=wid*QBLK+r32;
  #define CMASK(P0,P1,t) do{int jb_=(t)-(NT-4); if(jb_>=0)cmask(P0,P1,jb_,qrel,hi);}while(0)
  bool resc=false;
  #define START(P0,P1) do{ const float rm=rowmax(P0,P1); resc=false; \
    { const float dl=rm; mhat=fadd_s(mhat,dl); \
      _Pragma("unroll") for(int r=0;r<16;++r){P0[r]=fsub_s(P0[r],dl);P1[r]=fsub_s(P1[r],dl);} \
      } \
    _Pragma("unroll") for(int r=0;r<16;++r)P0[r]=__builtin_amdgcn_exp2f(P0[r]); }while(0)
  #define RESC() do{ if(resc){ asm volatile("s_waitcnt lgkmcnt(0)":::"memory"); \
      _Pragma("unroll") for(int d_=0;d_<2;++d_) _Pragma("unroll") for(int r=0;r<16;++r)o[d_][r]*=wsf[crow(r,hi)]; } }while(0)
  f32x16 pA0,pA1,pB0,pB1;
  int sl_prev=0,sl_cur=0,sl_next=SLOTB;
  #define ROT() do{sl_prev=sl_cur;sl_cur=sl_next;sl_next=(sl_next==(NSLOT-1)*SLOTB)?0:sl_next+SLOTB;}while(0)
  DMA_K(2,2*SLOTB);
  WAIT_BAR(3);
  qkt(pA0,pA1,Kbase,qr,zero16,r32,hi);asm volatile("s_nop 15\n\ts_nop 7":"+v"(pA0),"+v"(pA1));KBIAS(pA0,pA1,0);CMASK(pA0,pA1,0);
  START(pA0,pA1);
  _Pragma("unroll") for(int r=0;r<16;++r)pA1[r]=__builtin_amdgcn_exp2f(pA1[r]);
  { const float nm_=-mhat; _Pragma("unroll") for(int g_=0;g_<4;++g_){ const f32x4v c0_=LDC(ckl+64+8*g_), c1_=LDC(ckl+64+32+8*g_);
      _Pragma("unroll") for(int i_=0;i_<4;++i_){ pB0[4*g_+i_]=nm_-c0_[i_]; pB1[4*g_+i_]=nm_-c1_[i_]; } } }
  WAIT_BAR(0);
  DMA_K(3,0);DMA_V(1,SLOTB);
  ROT();
  kload8(kf,kp0+sl_cur);
  WAIT_BAR(2);
  s16x4 vlo[8],vhi[8]; u32x4 pw0,pw1,pw2,pw3;
  #define PKW(P,B) cvtpk_s(P[B],P[B+1])
  #define PAF(k) __builtin_bit_cast(bf16x8,pw##k)
  #define VFR(i) (bf16x8){vlo[i][0],vlo[i][1],vlo[i][2],vlo[i][3],vhi[i][0],vhi[i][1],vhi[i][2],vhi[i][3]}
  #define PIN(x) asm volatile("":"+v"(x))
  #define MX3(a,b,c) __builtin_fmaxf(__builtin_fmaxf((a),(b)),(c))
  #define GAPA(MF,A0,A1,A2,A3,W0,W1,PW) do{ MF; sacc+=A0; sacc+=A1; sacc+=A2; sacc+=A3; PIN(sacc); W0; W1; PIN(PW); SBAR(); }while(0)
  #define EX(v) __builtin_amdgcn_exp2f(v)
  #define GAPB(MF,X,B,PN,CN,NXT) do{ MF; X[B]=EX(X[B]); X[B+1]=EX(X[B+1]); X[B+2]=EX(X[B+2]); X[B+3]=EX(X[B+3]); PIN(X); \
      PN[B]=nm_-cpre_[0]; PN[B+1]=nm_-cpre_[1]; PN[B+2]=nm_-cpre_[2]; PN[B+3]=nm_-cpre_[3]; PIN(PN); cpre_=LDC(ckn_+(NXT)); SBAR(); }while(0)
  #define VRD(i) do{ vlo[i]=vtr(vp_+(((i)>>2)*4096+((i)&3)*1024)); vhi[i]=vtr(vp_+(((i)>>2)*4096+((i)&3)*1024+512)); }while(0)
  #define KRD(G,j) do{ if(G){ kload2(kf,kp0+sl_next,j); SBAR(); } }while(0)
  #define STEP(C0,C1,P0,P1,t,GK,GV,GL) do{ SBAR(); \
    const lds_cptr vp_=vp0+sl_prev; \
    VRD(0); SBAR(); float sacc=(P0[0]+P0[1]); \
    GAPA(C0=__builtin_amdgcn_mfma_f32_32x32x16_bf16(kf[0],qr[0],C0,0,0,0), P0[2],P0[3],P0[4],P0[5],     pw0[0]=PKW(P0,0), pw0[1]=PKW(P0,2), pw0); \
    VRD(4); SBAR(); GAPA(C1=__builtin_amdgcn_mfma_f32_32x32x16_bf16(kf[1],qr[0],C1,0,0,0), P0[6],P0[7],P0[8],P0[9],     pw0[2]=PKW(P0,4), pw0[3]=PKW(P0,6), pw0); \
    VRD(1); SBAR(); GAPA(C0=__builtin_amdgcn_mfma_f32_32x32x16_bf16(kf[2],qr[1],C0,0,0,0),   P0[10],P0[11],P0[12],P0[13], pw1[0]=PKW(P0,8), pw1[1]=PKW(P0,10), pw1); \
    VRD(5); SBAR(); GAPA(C1=__builtin_amdgcn_mfma_f32_32x32x16_bf16(kf[3],qr[1],C1,0,0,0),   P0[14],P0[15],P1[0],P1[1],   pw1[2]=PKW(P0,12),pw1[3]=PKW(P0,14), pw1); \
    VRD(2); SBAR(); GAPA(C0=__builtin_amdgcn_mfma_f32_32x32x16_bf16(kf[4],qr[2],C0,0,0,0),   P1[2],P1[3],P1[4],P1[5],     pw2[0]=PKW(P1,0), pw2[1]=PKW(P1,2), pw2); \
    VRD(6); SBAR(); GAPA(C1=__builtin_amdgcn_mfma_f32_32x32x16_bf16(kf[5],qr[2],C1,0,0,0),   P1[6],P1[7],P1[8],P1[9],     pw2[2]=PKW(P1,4), pw2[3]=PKW(P1,6), pw2); \
    VRD(3); SBAR(); GAPA(C0=__builtin_amdgcn_mfma_f32_32x32x16_bf16(kf[6],qr[3],C0,0,0,0),   P1[10],P1[11],P1[12],P1[13], pw3[0]=PKW(P1,8), pw3[1]=PKW(P1,10), pw3); \
    VRD(7); SBAR(); GAPA(C1=__builtin_amdgcn_mfma_f32_32x32x16_bf16(kf[7],qr[3],C1,0,0,0),   P1[14],P1[15],0.f,0.f,       pw3[2]=PKW(P1,12),pw3[3]=PKW(P1,14), pw3); \
    l_reg+=sacc; \
    if(GK){DMA_K((t)+3,sl_cur);} if(GV){DMA_V((t)+1,sl_next);} \
    CMASK(C0,C1,t); \
    { float a=MX3(C0[0],C0[1],C1[0]),b=MX3(C0[2],C0[3],C1[1]); a=MX3(a,C1[2],C1[3]); \
      _Pragma("unroll") for(int r=4;r<16;r+=4){a=MX3(a,C0[r],C0[r+1]);b=MX3(b,C0[r+2],C0[r+3]);a=MX3(a,C1[r],C1[r+1]);b=MX3(b,C1[r+2],C1[r+3]);} \
      float rm=__builtin_fmaxf(a,b); { auto rr=__builtin_amdgcn_permlane32_swap(__float_as_uint(rm),__float_as_uint(rm),false,false); rm=__builtin_fmaxf(__uint_as_float(rr[0]),__uint_as_float(rr[1])); } \
      resc=false; \
      if(__builtin_expect(__any(rm>(float)THRL),0)){ const float dl=__builtin_fmaxf(rm,0.f); mhat+=dl; \
        _Pragma("unroll") for(int r=0;r<16;++r){C0[r]-=dl;C1[r]-=dl;} \
        const float f=__builtin_amdgcn_exp2f(-dl); l_reg*=f; if(hi==0)wsf[r32]=f; resc=true; } } \
    const float nm_=-mhat; const lds_fptr ckn_=ckl+((t)+1)*64; f32x4v cpre_=LDC(ckn_); \
    SBAR(); \
    GAPB(o[0]=__builtin_amdgcn_mfma_f32_32x32x16_bf16(PAF(0),VFR(0),o[0],0,0,0), C0,0, P0,0,8); \
    GAPB(o[1]=__builtin_amdgcn_mfma_f32_32x32x16_bf16(PAF(0),VFR(4),o[1],0,0,0), C0,4, P0,4,16); \
    KRD(GL,0); GAPB(o[0]=__builtin_amdgcn_mfma_f32_32x32x16_bf16(PAF(1),VFR(1),o[0],0,0,0), C0,8, P0,8,24); \
    KRD(GL,1); GAPB(o[1]=__builtin_amdgcn_mfma_f32_32x32x16_bf16(PAF(1),VFR(5),o[1],0,0,0), C0,12, P0,12,32); \
    KRD(GL,2); GAPB(o[0]=__builtin_amdgcn_mfma_f32_32x32x16_bf16(PAF(2),VFR(2),o[0],0,0,0), C1,0, P1,0,40); \
    KRD(GL,3); GAPB(o[1]=__builtin_amdgcn_mfma_f32_32x32x16_bf16(PAF(2),VFR(6),o[1],0,0,0), C1,4, P1,4,48); \
    GAPB(o[0]=__builtin_amdgcn_mfma_f32_32x32x16_bf16(PAF(3),VFR(3),o[0],0,0,0), C1,8, P1,8,56); \
    GAPB(o[1]=__builtin_amdgcn_mfma_f32_32x32x16_bf16(PAF(3),VFR(7),o[1],0,0,0), C1,12, P1,12,56); \
    }while(0)
  int t=1;
  #undef CMASK
  #define CMASK(P0,P1,t) do{}while(0)
  for(;t+5<NT;t+=2){
    STEP(pB0,pB1,pA0,pA1,t,true,true,true);     WAIT_BAR(2); RESC(); ROT();
    STEP(pA0,pA1,pB0,pB1,t+1,true,true,true);   WAIT_BAR(2); RESC(); ROT();
  }
  #undef CMASK
  #define CMASK(P0,P1,t) do{int jb_=(t)-(NT-4); if(jb_>=0)cmask(P0,P1,jb_,qrel,hi);}while(0)
  #define ENDW(tt) do{ if((tt)+3<NT){WAIT_BAR(2);} else if((tt)+2<NT){WAIT_BAR(1);} else {WAIT_BAR(0);} }while(0)
  for(;t+1<NT;t+=2){
    STEP(pB0,pB1,pA0,pA1,t,(t+3<NT),(t+1<NT),(t+1<NT));       ENDW(t);   RESC(); ROT();
    STEP(pA0,pA1,pB0,pB1,t+1,(t+4<NT),(t+2<NT),(t+2<NT));     ENDW(t+1); RESC(); ROT();
  }
  STEP(pB0,pB1,pA0,pA1,NT-1,false,false,false); RESC();
  { float sacc=pB0[0]+pB0[1]; _Pragma("unroll") for(int r=2;r<16;++r)sacc+=pB0[r]; _Pragma("unroll") for(int r=0;r<16;++r)sacc+=pB1[r]; l_reg+=sacc;
    pw0=(u32x4){PKW(pB0,0),PKW(pB0,2),PKW(pB0,4),PKW(pB0,6)};pw1=(u32x4){PKW(pB0,8),PKW(pB0,10),PKW(pB0,12),PKW(pB0,14)};pw2=(u32x4){PKW(pB1,0),PKW(pB1,2),PKW(pB1,4),PKW(pB1,6)};pw3=(u32x4){PKW(pB1,8),PKW(pB1,10),PKW(pB1,12),PKW(pB1,14)};
    SBAR(); pv(o,vb0+sl_cur,PAF(0),PAF(1),PAF(2),PAF(3)); }
  #undef PKW
  #undef PAF
  #undef VFR
  #undef PIN
  #undef MX3
  #undef GAPA
  #undef GAPB
  #undef EX
  #undef VRD
  #undef KRD
  #undef STEP
  #undef ENDW
  {auto rr=__builtin_amdgcn_permlane32_swap(__float_as_uint(l_reg),__float_as_uint(l_reg),false,false);l_reg=__uint_as_float(rr[0])+__uint_as_float(rr[1]);}
  if(hi==0)wsf[32+r32]=l_reg;asm volatile("s_waitcnt lgkmcnt(0)":::"memory");
  float rli[16];
  #pragma unroll
  for(int r=0;r<16;++r)rli[r]=__builtin_amdgcn_rcpf(wsf[32+crow(r,hi)]);
  bf16*Ow=O+(rowbase+q0+wid*QBLK)*QP+h*D;
  { bf16*stg=(bf16*)(shm+LDS_OST)+wid*2048;
    #pragma unroll
    for(int r=0;r<16;++r){const int orow=crow(r,hi);
      #pragma unroll
      for(int d0=0;d0<2;++d0)stg[orow*64+d0*32+r32]=__float2bfloat16(o[d0][r]*rli[r]);}
    asm volatile("s_waitcnt lgkmcnt(0)":::"memory");
    #pragma unroll
    for(int i=0;i<4;++i){const int row=i*8+(lane>>3),ch=lane&7; const u32x4 v=*(const u32x4*)(stg+row*64+ch*8); ATTN_STORE16(Ow+(long)row*QP+ch*8,v);} }
  asm volatile("s_waitcnt lgkmcnt(0)\n\ts_barrier":::"memory");
  #undef KBIAS
  #undef LDC
  #undef DMA_K
  #undef DMA_V
  #undef CMASK
  #undef START
  #undef RESC
  #undef ROT
}
constexpr int ATTN_LDS_BYTES=LDS_BYTES;
struct AttnTensors { const bf16* Q; const bf16* K; const bf16* V; bf16* O; const float* CK; const float* KMAX; const float* QS; };
struct AttnUnit { int bh; int qb; };
struct StaticOrder {
  int vcu,G; const int* ORD;
  __device__ __forceinline__ explicit StaticOrder(int grid,int block,const int*ord):vcu((grid%8==0)?(block%8)*(grid/8)+block/8:block),G(grid),ORD(ord){}
  __device__ __forceinline__ bool next(int i,AttnUnit&u)const{ const int v=vcu+(i>>1)*G; if(v>=256)return false; const int s=v&15; u.bh=(G==256)?__builtin_amdgcn_readfirstlane(ORD[2*v+(i&1)]):(v>>4); u.qb=(i&1)?s:31-s; return true; }
  __device__ __forceinline__ void a_ready(const AttnUnit&)const{}
  __device__ __forceinline__ void done(const AttnUnit&)const{}
};
template<class Sched,int THRL=8> __device__ __forceinline__ void attn_phase(char*lds,const AttnTensors&T,const Sched&S){
  AttnUnit u;
  for(int i=0;S.next(i,u);++i){ S.a_ready(u); attn_unit<THRL>(u.bh/NHEAD,u.bh%NHEAD,u.qb,T.Q,T.K,T.V,T.O,T.CK+(long)u.bh*SEQ,T.KMAX+u.bh*(SEQ/KVBLK),T.QS+(u.bh*NQB+u.qb)*2,lds); S.done(u); }
}
#undef SBAR
#undef WAIT_BAR
}
constexpr int BATCH = 2, SEQ = 8192, DM = 1024, DEPTH = 2, NMEM = 256, M = BATCH * SEQ, FFH = 2816, NIN = 3592, NINP = 3840, MROWS = BATCH * NMEM;
constexpr float EPS = 1e-6f, LOG2E = 1.4426950408889634f, C2Q = 0.125f * 1.4426950408889634f;
constexpr int NWAVES = 8, NTHREADS = 512;
constexpr size_t MiB = 1u << 20;
constexpr size_t WS_W1A = 0, WS_W1B = 11 * MiB, WS_WIN = 33 * MiB / 2, WS_WOUT = 24 * MiB, WS_WQ = 26 * MiB, WS_WKV = 28 * MiB, WS_WO = 32 * MiB, WS_W2A = 34 * MiB, WS_W2B = 45 * MiB;
constexpr size_t WS_MEMN = 51 * MiB, WS_KV = 52 * MiB, WS_SSQ = 54 * MiB, WS_LB = 55 * MiB, WS_C2 = 55 * MiB + 65536, WS_FF = 56 * MiB, WS_XB = 58 * MiB;
constexpr size_t WS_ACT = 90 * MiB, WS_QO = 90 * MiB, WS_VH = 122 * MiB, WS_GH = 138 * MiB, WS_LF = 154 * MiB, WS_FK = 186 * MiB, WS_FV = 202 * MiB, WS_END = 218 * MiB;
constexpr size_t WS_PB = 90 * MiB, WS_WQK = 218 * MiB, WS_VWO = 222 * MiB, WS_END2 = 226 * MiB;
constexpr int LDS_BYTES = 147456;

#define GAS __attribute__((address_space(1)))
#define LAS __attribute__((address_space(3)))
typedef unsigned short bf16;
typedef unsigned v4u __attribute__((ext_vector_type(4)));
typedef unsigned v2u __attribute__((ext_vector_type(2)));
typedef float f32x4 __attribute__((ext_vector_type(4)));
using pg8::cvt_pk_bf16;
__device__ __forceinline__ float bf2f(unsigned short h) { return __uint_as_float(((unsigned)h) << 16); }
__device__ __forceinline__ float bflo(unsigned w) { return __uint_as_float(w << 16); }
__device__ __forceinline__ float bfhi(unsigned w) { return __uint_as_float(w & 0xffff0000u); }
__device__ __forceinline__ unsigned short f2bf(float f) { return (unsigned short)(cvt_pk_bf16(f, 0.f) & 0xffffu); }
__device__ __forceinline__ float wave_sum(float v) {
#pragma unroll
    for (int o = 1; o < 64; o <<= 1) v += __shfl_xor(v, o);
    return v;
}
__device__ __forceinline__ float wave_max(float v) {
#pragma unroll
    for (int o = 1; o < 64; o <<= 1) v = fmaxf(v, __shfl_xor(v, o));
    return v;
}
__device__ __forceinline__ float silu_f(float x) { return x * __builtin_amdgcn_rcpf(1.f + __expf(-x)); }
__device__ __forceinline__ float logsig_f(float x) { return fminf(x, 0.f) - __logf(1.f + __expf(-fabsf(x))); }

__device__ __forceinline__ float row_rstd(const float* ssq, int row, int fq) {
    const f32x4 v = *(const f32x4*)(ssq + (size_t)row * 16 + fq * 4);
    float s = (v[0] + v[1]) + (v[2] + v[3]);
    s += __shfl_xor(s, 16); s += __shfl_xor(s, 32);
    return __builtin_amdgcn_rsqf(s * (1.f / DM) + EPS);
}
__device__ __forceinline__ void row_rstd4(const float* ssq, int row0, int fq, float (&rs)[4]) {
    f32x4 v[4];
#pragma unroll
    for (int m = 0; m < 4; ++m) v[m] = *(const f32x4*)(ssq + (size_t)(row0 + m * 16) * 16 + fq * 4);
#pragma unroll
    for (int m = 0; m < 4; ++m) { float t = (v[m][0] + v[m][1]) + (v[m][2] + v[m][3]); t += __shfl_xor(t, 16); t += __shfl_xor(t, 32); rs[m] = __builtin_amdgcn_rsqf(t * (1.f / DM) + EPS); }
}
__device__ __forceinline__ v4u pack8(const f32x4 a, const f32x4 b) { v4u w; w.x = cvt_pk_bf16(a[0], a[1]); w.y = cvt_pk_bf16(a[2], a[3]); w.z = cvt_pk_bf16(b[0], b[1]); w.w = cvt_pk_bf16(b[2], b[3]); return w; }

struct EpiSwiglu {
    static constexpr bool PERM = true, AFTER_DRAIN = false;
    bf16* O; const float* ssq;
    __device__ __forceinline__ void operator()(const f32x4 (&acc)[2][2][4][2], const pg8::Unit& u, int wr, int wc, int fr, int fq) const {
        const int row0 = u.pm * 256 + wr * 64 + fr, col0 = u.pn * 128 + wc * 32 + 8 * fq;
#pragma unroll
        for (int ai = 0; ai < 2; ++ai) { float rsv[4]; row_rstd4(ssq, row0 + ai * 128, fq, rsv);
#pragma unroll
            for (int m = 0; m < 4; ++m) {
                const int row = row0 + ai * 128 + m * 16; const float rs = rsv[m], c = -rs * LOG2E, rs2 = rs * rs;
                f32x4 e0 = acc[ai][0][m][0] * c, e1 = acc[ai][0][m][1] * c;
#pragma unroll
                for (int i = 0; i < 4; ++i) { e0[i] = __builtin_amdgcn_exp2f(e0[i]); e1[i] = __builtin_amdgcn_exp2f(e1[i]); }
                e0 = e0 + 1.0f; e1 = e1 + 1.0f;
#pragma unroll
                for (int i = 0; i < 4; ++i) { e0[i] = __builtin_amdgcn_rcpf(e0[i]); e1[i] = __builtin_amdgcn_rcpf(e1[i]); }
                const f32x4 h0 = (acc[ai][0][m][0] * acc[ai][1][m][0]) * rs2 * e0, h1 = (acc[ai][0][m][1] * acc[ai][1][m][1]) * rs2 * e1;
                *(v4u*)(O + (size_t)row * FFH + col0) = pack8(h0, h1);
            } }
    }
};
struct EpiRes {
    static constexpr bool PERM = true, AFTER_DRAIN = false;
    bf16* xb; float* ssq; float alpha;
    __device__ __forceinline__ void operator()(const f32x4 (&acc)[2][2][4][2], const pg8::Unit& u, int wr, int wc, int fr, int fq) const {
        const int row0 = u.pm * 256 + wr * 64 + fr, col0 = u.pn * 256 + wc * 32 + 8 * fq;
#pragma unroll
        for (int ai = 0; ai < 2; ++ai)
#pragma unroll
            for (int m = 0; m < 4; ++m) {
                const int row = row0 + ai * 128 + m * 16; float ss = 0.f;
#pragma unroll
                for (int bj = 0; bj < 2; ++bj) {
                    const size_t off = (size_t)row * DM + col0 + bj * 128;
                    const v4u b = *(const v4u*)(xb + off);
                    f32x4 v0, v1; v0[0] = bflo(b.x); v0[1] = bfhi(b.x); v0[2] = bflo(b.y); v0[3] = bfhi(b.y); v1[0] = bflo(b.z); v1[1] = bfhi(b.z); v1[2] = bflo(b.w); v1[3] = bfhi(b.w);
                    v0 = v0 + alpha * acc[ai][bj][m][0]; v1 = v1 + alpha * acc[ai][bj][m][1];
                    const v4u w = pack8(v0, v1); *(v4u*)(xb + off) = w;
                    const float r0 = bflo(w.x), r1 = bfhi(w.x), r2 = bflo(w.y), r3 = bfhi(w.y), r4 = bflo(w.z), r5 = bfhi(w.z), r6 = bflo(w.w), r7 = bfhi(w.w);
                    ss += (r0 * r0 + r1 * r1) + (r2 * r2 + r3 * r3) + (r4 * r4 + r5 * r5) + (r6 * r6 + r7 * r7);
                }
                ss += __shfl_xor(ss, 16); ss += __shfl_xor(ss, 32);
                if (fq == 0) ssq[(size_t)row * 16 + u.pn * 4 + wc] = ss;
            }
    }
};
struct EpiPlain {
    static constexpr bool PERM = true, AFTER_DRAIN = false;
    bf16* O; int ldc; const float* ssq; float scale;
    __device__ __forceinline__ void operator()(const f32x4 (&acc)[2][2][4][2], const pg8::Unit& u, int wr, int wc, int fr, int fq) const {
        const int row0 = u.pm * 256 + wr * 64 + fr, col0 = u.pn * 256 + wc * 32 + 8 * fq;
#pragma unroll
        for (int ai = 0; ai < 2; ++ai)
#pragma unroll
            for (int m = 0; m < 4; ++m) {
                const int row = row0 + ai * 128 + m * 16; const float rs = (ssq ? row_rstd(ssq, row, fq) : 1.f) * scale;
#pragma unroll
                for (int bj = 0; bj < 2; ++bj) *(v4u*)(O + (size_t)row * ldc + col0 + bj * 128) = pack8(acc[ai][bj][m][0] * rs, acc[ai][bj][m][1] * rs);
            }
    }
};
struct EpiWin {
    static constexpr bool PERM = true, AFTER_DRAIN = false;
    unsigned char* wsb; const float* lb; const float* fbias;
    __device__ __forceinline__ void operator()(const f32x4 (&acc)[2][2][4][2], const pg8::Unit& u, int wr, int wc, int fr, int fq) const {
        const int row0 = u.pm * 256 + wr * 64 + fr, pn = (u.pn == 2) ? 7 : (u.pn == 7) ? 2 : u.pn, cw = wc * 32 + 8 * fq;
        bf16* const QO = (bf16*)(wsb + WS_QO); bf16* const VH = (bf16*)(wsb + WS_VH); bf16* const GH = (bf16*)(wsb + WS_GH); bf16* const FK = (bf16*)(wsb + WS_FK); bf16* const FV = (bf16*)(wsb + WS_FV);
        float* const LF = (float*)(wsb + WS_LF); float* const FF = (float*)(wsb + WS_FF); const float* const ssq = (const float*)(wsb + WS_SSQ);
        if (pn == 14) {
            if (wc == 0 && fq == 0) {
                const f32x4 fb0 = *(const f32x4*)fbias, fb1 = *(const f32x4*)(fbias + 4);
#pragma unroll
                for (int ai = 0; ai < 2; ++ai)
#pragma unroll
                    for (int m = 0; m < 4; ++m) {
                        const int row = row0 + ai * 128 + m * 16;
                        const f32x4 sv = *(const f32x4*)(ssq + (size_t)row * 16), sv1 = *(const f32x4*)(ssq + (size_t)row * 16 + 4), sv2 = *(const f32x4*)(ssq + (size_t)row * 16 + 8), sv3 = *(const f32x4*)(ssq + (size_t)row * 16 + 12);
                        const float st = ((sv[0] + sv[1]) + (sv[2] + sv[3])) + ((sv1[0] + sv1[1]) + (sv1[2] + sv1[3])) + ((sv2[0] + sv2[1]) + (sv2[2] + sv2[3])) + ((sv3[0] + sv3[1]) + (sv3[2] + sv3[3]));
                        const float rs = __builtin_amdgcn_rsqf(st * (1.f / DM) + EPS);
                        f32x4 a = acc[ai][0][m][0] * rs, b = acc[ai][0][m][1] * rs;
#pragma unroll
                        for (int i = 0; i < 4; ++i) { a[i] = logsig_f(a[i] + fb0[i]) * LOG2E; b[i] = logsig_f(b[i] + fb1[i]) * LOG2E; }
                        *(f32x4*)(FF + (size_t)row * 8) = a; *(f32x4*)(FF + (size_t)row * 8 + 4) = b;
                        asm volatile("" ::: "memory");
                    }
            }
            return;
        }
        const int grp = pn >> 1, cb = (pn & 1) * 256 + cw;
#define WIN_LOOP(...) _Pragma("unroll") for (int ai = 0; ai < 2; ++ai) { _Pragma("unroll") for (int m = 0; m < 4; ++m) { const int row = row0 + ai * 128 + m * 16; const float rs = row_rstd(ssq, row, fq); \
            _Pragma("unroll") for (int bj = 0; bj < 2; ++bj) { f32x4 a = acc[ai][bj][m][0] * rs, b = acc[ai][bj][m][1] * rs; const int c = cb + bj * 128; __VA_ARGS__ } } asm volatile("" ::: "memory"); }
        if (grp == 0) { WIN_LOOP( _Pragma("unroll") for (int i = 0; i < 4; ++i) { a[i] = silu_f(a[i]); b[i] = silu_f(b[i]); } *(v4u*)(QO + (size_t)row * DM + c) = pack8(a, b); ) }
        else if (grp == 3) { WIN_LOOP( _Pragma("unroll") for (int i = 0; i < 4; ++i) { a[i] = silu_f(a[i]); b[i] = silu_f(b[i]); } *(v4u*)(GH + (size_t)row * 512 + c) = pack8(a, b); ) }
        else if (grp == 1) {
            f32x4 l0[2], l1[2];
#pragma unroll
            for (int bj = 0; bj < 2; ++bj) { l0[bj] = *(const f32x4*)(lb + cb + bj * 128); l1[bj] = *(const f32x4*)(lb + cb + bj * 128 + 4); }
            WIN_LOOP( _Pragma("unroll") for (int i = 0; i < 4; ++i) { const float s0 = fminf(a[i], 0.f) - __logf(1.f + __expf(-fabsf(a[i]))), s1 = fminf(b[i], 0.f) - __logf(1.f + __expf(-fabsf(b[i]))); const float la = l0[bj][i], lbv = l1[bj][i];
                    a[i] = la > 0.f ? __logf(la + (1.f - la) * __expf(s0)) : s0; b[i] = lbv > 0.f ? __logf(lbv + (1.f - lbv) * __expf(s1)) : s1; }
                *(f32x4*)(LF + (size_t)row * 512 + c) = a; *(f32x4*)(LF + (size_t)row * 512 + c + 4) = b; __builtin_amdgcn_sched_barrier(0); ) }
        else if (grp == 2) { WIN_LOOP( *(v4u*)(VH + (size_t)row * 512 + c) = pack8(a, b); ) }
        else if (grp == 4) { WIN_LOOP( *(v4u*)(QO + (size_t)row * DM + 512 + c) = pack8(a * C2Q, b * C2Q); ) }
        else if (grp == 5) { WIN_LOOP( *(v4u*)(FK + (size_t)row * 512 + c) = pack8(a, b); ) }
        else { WIN_LOOP( *(v4u*)(FV + (size_t)row * 512 + c) = pack8(a, b); ) }
#undef WIN_LOOP
    }
};

struct EpiFold {
    static constexpr bool PERM = true, AFTER_DRAIN = false;
    bf16* O; bool modeB; float scale;
    __device__ __forceinline__ void operator()(const f32x4 (&acc)[2][2][4][2], const pg8::Unit& u, int wr, int wc, int fr, int fq) const {
        const int hd = u.pm >> 3, b = (u.pm >> 2) & 1, q = u.pm & 3;
        const int rowb = modeB ? q * 256 : b * 1024 + hd * 256, colb = modeB ? hd * 256 : q * 256; bf16* Ob = O + (modeB ? (size_t)b * 1024 * 1024 : 0);
#pragma unroll
        for (int ai = 0; ai < 2; ++ai)
#pragma unroll
            for (int m = 0; m < 4; ++m) { const int row = rowb + ai * 128 + wr * 64 + m * 16 + fr;
#pragma unroll
                for (int bj = 0; bj < 2; ++bj) *(v4u*)(Ob + (size_t)row * 1024 + colb + bj * 128 + wc * 32 + 8 * fq) = pack8(acc[ai][bj][m][0] * scale, acc[ai][bj][m][1] * scale); }
    }
};
struct EpiSoftmax {
    static constexpr bool PERM = true, AFTER_DRAIN = false;
    bf16* P; const float* ssq; LAS float* xch;
    __device__ __forceinline__ void operator()(const f32x4 (&acc_)[2][2][4][2], const pg8::Unit& u, int wr, int wc, int fr, int fq) const {
        f32x4 (&acc)[2][2][4][2] = const_cast<f32x4 (&)[2][2][4][2]>(acc_);
        const int row0 = u.pm * 256 + wr * 64 + fr, lrow0 = wr * 64 + fr;
#pragma unroll
        for (int ai = 0; ai < 2; ++ai)
#pragma unroll
            for (int m = 0; m < 4; ++m) { const float rs = row_rstd(ssq, row0 + ai * 128 + m * 16, fq); float mx = -3.0e38f;
#pragma unroll
                for (int bj = 0; bj < 2; ++bj)
#pragma unroll
                    for (int n = 0; n < 2; ++n) { const f32x4 a = acc[ai][bj][m][n]; mx = fmaxf(mx, fmaxf(fmaxf(a[0], a[1]), fmaxf(a[2], a[3]))); }
                mx *= rs; mx = fmaxf(mx, __shfl_xor(mx, 16)); mx = fmaxf(mx, __shfl_xor(mx, 32));
                if (fq == 0) xch[(lrow0 + ai * 128 + m * 16) * 4 + wc] = mx; }
        asm volatile("s_waitcnt lgkmcnt(0)" ::: "memory"); __builtin_amdgcn_s_barrier(); asm volatile("" ::: "memory");
#pragma unroll
        for (int ai = 0; ai < 2; ++ai)
#pragma unroll
            for (int m = 0; m < 4; ++m) { const f32x4 x4 = *(const LAS f32x4*)(xch + (lrow0 + ai * 128 + m * 16) * 4); const float mrow = fmaxf(fmaxf(x4[0], x4[1]), fmaxf(x4[2], x4[3])), rs = row_rstd(ssq, row0 + ai * 128 + m * 16, fq); float sm = 0.f;
#pragma unroll
                for (int bj = 0; bj < 2; ++bj)
#pragma unroll
                    for (int n = 0; n < 2; ++n) { f32x4 a = acc[ai][bj][m][n];
#pragma unroll
                        for (int i = 0; i < 4; ++i) { a[i] = __expf(a[i] * rs - mrow); sm += a[i]; }
                        asm volatile("" ::: "memory");
                        acc[ai][bj][m][n] = a; }
                sm += __shfl_xor(sm, 16); sm += __shfl_xor(sm, 32);
                if (fq == 0) xch[1024 + (lrow0 + ai * 128 + m * 16) * 4 + wc] = sm; }
        asm volatile("s_waitcnt lgkmcnt(0)" ::: "memory"); __builtin_amdgcn_s_barrier(); asm volatile("" ::: "memory");
#pragma unroll
        for (int ai = 0; ai < 2; ++ai)
#pragma unroll
            for (int m = 0; m < 4; ++m) { const f32x4 x4 = *(const LAS f32x4*)(xch + 1024 + (lrow0 + ai * 128 + m * 16) * 4); const float inv = __builtin_amdgcn_rcpf((x4[0] + x4[1]) + (x4[2] + x4[3]));
#pragma unroll
                for (int bj = 0; bj < 2; ++bj) *(v4u*)(P + (size_t)(row0 + ai * 128 + m * 16) * DM + u.pn * 256 + bj * 128 + wc * 32 + 8 * fq) = pack8(acc[ai][bj][m][0] * inv, acc[ai][bj][m][1] * inv); }
        asm volatile("s_waitcnt lgkmcnt(0)" ::: "memory"); __builtin_amdgcn_s_barrier(); asm volatile("" ::: "memory");
    }
};
struct Args { const float* in[23]; float* out; unsigned char* ws; };
struct Frame {
    LAS unsigned char* lds; int tid, lane, wave, vcu, G;
    float* out; unsigned char* ws;
};
#define LDS_WAIT() asm volatile("s_waitcnt lgkmcnt(0)" ::: "memory")

__device__ __forceinline__ void transpose_item(const float* W, int K, int N, bf16* WT, int rs, int off, const float* sc, LAS float* scr, int item, int nblk, int lane, int swp) {
    const int kb = item / nblk, nb = item % nblk, k0 = 64 * kb, n0 = 32 * nb;
    const int n = n0 + (lane & 31);
    float tv[32];
#pragma unroll
    for (int i = 0; i < 32; ++i) tv[i] = 0.f;
    if (n < N) { const float* p = W + (size_t)(k0 + (lane >> 5)) * N + n; int stepv = 2 * N; asm volatile("" : "+v"(stepv));
#pragma unroll
        for (int i = 0; i < 32; ++i) { tv[i] = *p; p += stepv; } }
#pragma unroll
    for (int i = 0; i < 32; ++i) scr[(2 * i + (lane >> 5)) * 33 + (lane & 31)] = tv[i];
    LDS_WAIT(); asm volatile("" ::: "memory");
    const int c = lane & 7;
    f32x4 s0 = {1.f, 1.f, 1.f, 1.f}, s1 = s0; if (sc) { s0 = *(const f32x4*)(sc + k0 + 8 * c); s1 = *(const f32x4*)(sc + k0 + 8 * c + 4); }
#pragma unroll
    for (int j = 0; j < 4; ++j) { const int nn = (lane >> 3) + 8 * j; const LAS float* s = scr + (8 * c) * 33 + nn;
        v4u o; o.x = cvt_pk_bf16(s[0 * 33] * s0[0], s[1 * 33] * s0[1]); o.y = cvt_pk_bf16(s[2 * 33] * s0[2], s[3 * 33] * s0[3]); o.z = cvt_pk_bf16(s[4 * 33] * s1[0], s[5 * 33] * s1[1]); o.w = cvt_pk_bf16(s[6 * 33] * s1[2], s[7 * 33] * s1[3]);
        const int ng = n0 + nn, t256 = ng >> 8, ts256 = (t256 == 2) ? 7 : (t256 == 7) ? 2 : t256, dr = swp ? ts256 * 256 + (ng & 255) : (ng / 128) * rs + off + (ng % 128);
        *(v4u*)(WT + (size_t)dr * K + k0 + 8 * c) = o; }
    LDS_WAIT(); asm volatile("" ::: "memory");
}
__device__ __forceinline__ void row_to_bf16(const float* xrow, bf16* orow, float* ssqrow, bool normalise, int lane) {
    const f32x4* xr = (const f32x4*)xrow + lane; f32x4 v[4]; float s = 0.f;
#pragma unroll
    for (int j = 0; j < 4; ++j) { v[j] = xr[64 * j]; s += (v[j][0] * v[j][0] + v[j][1] * v[j][1]) + (v[j][2] * v[j][2] + v[j][3] * v[j][3]); }
    s = wave_sum(s);
    const float rs = normalise ? 1.0f / sqrtf(s * (1.f / DM) + EPS) : 1.f;
    v2u* o8 = (v2u*)orow + lane;
#pragma unroll
    for (int j = 0; j < 4; ++j) { v2u w; w.x = cvt_pk_bf16(v[j][0] * rs, v[j][1] * rs); w.y = cvt_pk_bf16(v[j][2] * rs, v[j][3] * rs); o8[64 * j] = w; }
    if (ssqrow && lane < 16) ssqrow[lane] = (lane == 0) ? s : 0.f;
}
__device__ __forceinline__ void prologue(Frame& F, const Args& A, int l) {
    LAS float* scr = (LAS float*)(F.lds + F.wave * 16384);
    const int gw = F.vcu * NWAVES + F.wave, NGW = F.G * NWAVES;
    unsigned char* ws = F.ws;
    const size_t oFF = (size_t)l * DM * FFH, oDD = (size_t)l * DM * DM;
    constexpr int I_GU = 16 * 88, I_DN = 44 * 32, I_IN = 16 * 120, I_SQ = 16 * 32;
    constexpr int NITEMS = 6 * 1408 + I_IN + 4 * I_SQ;
    for (int it = gw; it < NITEMS; it += NGW) {
        int r = it, si, sci = -1, K = DM, N = FFH, rs = 128, off = 0, nblk = 32; size_t so = oFF, dsto;
        if (r < 6 * 1408) { const int w = r / 1408; r -= w * 1408; const int second = w >= 3, t = w % 3;
            if (t < 2) { si = (second ? 19 : 3) + t; sci = second ? 18 : 2; rs = 256; off = 128 * t; nblk = 88; dsto = second ? WS_W2A : WS_W1A; }
            else { si = second ? 21 : 5; K = FFH; N = DM; dsto = second ? WS_W2B : WS_W1B; } }
        else { r -= 6 * 1408;
            if (r < I_IN) { si = 7; sci = 6; N = NIN; nblk = 120; so = (size_t)l * DM * NIN; dsto = WS_WIN; }
            else { r -= I_IN; const int w = r / I_SQ; r -= w * I_SQ; N = DM; so = oDD;
                si = (w == 0) ? 11 : 14 + w; sci = (w == 1 || w == 2) ? 13 : -1;
                dsto = (w == 0) ? WS_WOUT : (w == 1) ? WS_WKV : (w == 2) ? WS_WKV + (size_t)DM * DM * 2 : WS_WO; } }
        transpose_item(A.in[si] + so, K, N, (bf16*)(ws + dsto), rs, off, sci >= 0 ? A.in[sci] + l * DM : nullptr, scr, r, nblk, F.lane, si == 7 ? 1 : 0);
    }
    for (int d = gw; d < DM; d += NGW) {
        const float sc = A.in[12][l * DM + d]; const f32x4* src = (const f32x4*)(A.in[14] + oDD + (size_t)d * DM) + F.lane; v2u* dst = (v2u*)((bf16*)(ws + WS_WQ) + (size_t)d * DM) + F.lane;
#pragma unroll
        for (int j = 0; j < 4; ++j) { const f32x4 v = src[64 * j] * sc; v2u w; w.x = cvt_pk_bf16(v[0], v[1]); w.y = cvt_pk_bf16(v[2], v[3]); dst[64 * j] = w; }
    }
    if (l == 0) {
        for (int m = gw; m < M; m += NGW) row_to_bf16(A.in[0] + (size_t)m * DM, (bf16*)(ws + WS_XB) + (size_t)m * DM, (float*)(ws + WS_SSQ) + (size_t)m * 16, false, F.lane);
        for (int m = gw; m < MROWS; m += NGW) row_to_bf16(A.in[1] + (size_t)m * DM, (bf16*)(ws + WS_MEMN) + (size_t)m * DM, nullptr, true, F.lane);
        for (int k = F.vcu * NTHREADS + F.tid; k < 512; k += F.G * NTHREADS) {
            float mx = -1e30f; for (int j = 0; j < DEPTH; ++j) mx = fmaxf(mx, A.in[8][j * 512 + k]);
            float den = 0.f; for (int j = 0; j < DEPTH; ++j) den += __expf(A.in[8][j * 512 + k] - mx);
            float cum = 0.f; for (int j = 0; j < DEPTH; ++j) { if (j > 0) cum += __expf(A.in[8][j * 512 + k] - mx) / den; ((float*)(ws + WS_LB))[j * 512 + k] = cum; }
        }
    }
}

__device__ __forceinline__ void fox_cumsum_unit(Frame& F, int bh) {
    const int b = bh >> 3, h = bh & 7; const float* FFp = (const float*)(F.ws + WS_FF); float* C2 = (float*)(F.ws + WS_C2);
    LAS float* wt = (LAS float*)F.lds;
    float v[16]; float run = 0.f;
#pragma unroll
    for (int i = 0; i < 16; ++i) v[i] = FFp[(size_t)(b * SEQ + F.tid * 16 + i) * 8 + h];
#pragma unroll
    for (int i = 0; i < 16; ++i) { run += v[i]; v[i] = run; }
    float inc = run;
#pragma unroll
    for (int o = 1; o < 64; o <<= 1) { const float t = __shfl_up(inc, o); if (F.lane >= o) inc += t; }
    if (F.lane == 63) wt[F.wave] = inc;
    __syncthreads();
    float base = inc - run;
    for (int w = 0; w < F.wave; ++w) base += wt[w];
#pragma unroll
    for (int i4 = 0; i4 < 4; ++i4) { f32x4 o4;
#pragma unroll
        for (int i = 0; i < 4; ++i) o4[i] = base + v[i4 * 4 + i];
        *(f32x4*)(C2 + (size_t)bh * SEQ + F.tid * 16 + i4 * 4) = o4; }
    __syncthreads();
}
constexpr size_t WS_KMAX = WS_LB + 8192, WS_QS = WS_LB + 16384, WS_ORD = WS_LB + 24576;
constexpr size_t WS_KMAX_ = 0;
__device__ __forceinline__ float sq8(const v4u w) { const float a0 = bflo(w.x), a1 = bfhi(w.x), a2 = bflo(w.y), a3 = bfhi(w.y), a4 = bflo(w.z), a5 = bfhi(w.z), a6 = bflo(w.w), a7 = bfhi(w.w); return (a0 * a0 + a1 * a1) + (a2 * a2 + a3 * a3) + (a4 * a4 + a5 * a5) + (a6 * a6 + a7 * a7); }
__device__ __forceinline__ float dot8(const v4u a, const v4u b) { return (bflo(a.x) * bflo(b.x) + bfhi(a.x) * bfhi(b.x)) + (bflo(a.y) * bflo(b.y) + bfhi(a.y) * bfhi(b.y)) + (bflo(a.z) * bflo(b.z) + bfhi(a.z) * bfhi(b.z)) + (bflo(a.w) * bflo(b.w) + bfhi(a.w) * bfhi(b.w)); }
__device__ __forceinline__ void fox_bounds(Frame& F) {
    const bf16* QO = (const bf16*)(F.ws + WS_QO); const bf16* FK = (const bf16*)(F.ws + WS_FK); const float* C2 = (const float*)(F.ws + WS_C2);
    float* KMAX = (float*)(F.ws + WS_KMAX); float* QS = (float*)(F.ws + WS_QS);
    if (F.wave < 4) return;
    const int gw = F.vcu * 4 + (F.wave - 4), NGW = F.G * 4;
    for (int item = gw; item < 2048 + 512; item += NGW) {
        if (item < 2048) { const int bh = item >> 7, t = item & 127, b = bh >> 3, h = bh & 7; const v4u* kp = (const v4u*)(FK + ((size_t)b * SEQ + t * 64 + F.lane) * 512 + h * 64);
            float k2 = 0.f;
#pragma unroll
            for (int d8 = 0; d8 < 8; ++d8) k2 += sq8(kp[d8]);
            k2 = wave_max(k2); if (F.lane == 0) KMAX[item] = sqrtf(k2);
        } else { const int it = item - 2048, bh = it >> 5, qb = it & 31, b = bh >> 3, h = bh & 7; float q2 = 0.f, sm = 3.0e38f;
#pragma unroll
            for (int r = 0; r < 4; ++r) { const int i = qb * 256 + F.lane + 64 * r; const size_t row = (size_t)b * SEQ + i;
                const v4u* qp = (const v4u*)(QO + row * DM + 512 + h * 64); const v4u* kp = (const v4u*)(FK + row * 512 + h * 64); float qq = 0.f, qk = 0.f;
#pragma unroll
                for (int d8 = 0; d8 < 8; ++d8) { const v4u qv = qp[d8]; qq += sq8(qv); qk += dot8(qv, kp[d8]); }
                q2 = fmaxf(q2, qq); sm = fminf(sm, qk - C2[(size_t)bh * SEQ + i]); }
            q2 = wave_max(q2); sm = -wave_max(-sm);
            if (F.lane == 0) { QS[it * 2] = sqrtf(q2); QS[it * 2 + 1] = sm; }
        }
    }
    if (F.wave == 4 && F.vcu < 256) {
        const int l16 = F.lane & 15; const float v = C2[(size_t)l16 * SEQ + SEQ - 1]; int rank = 0;
#pragma unroll
        for (int m = 0; m < 16; ++m) { const float vm = __shfl(v, m); rank += (vm < v || (vm == v && m < l16)) ? 1 : 0; }
        const int g = (F.vcu >> 4) & 15;
        const unsigned long long ma = __ballot(rank == g && F.lane < 16), mb = __ballot(rank == 15 - g && F.lane < 16);
        if (F.lane == 0) { int* ORD = (int*)(F.ws + WS_ORD); ORD[2 * F.vcu] = ma ? (int)__builtin_ctzll(ma) : g; ORD[2 * F.vcu + 1] = mb ? (int)__builtin_ctzll(mb) : 15 - g; }
    }
}
typedef short bf16x8_t __attribute__((ext_vector_type(8)));
__device__ __forceinline__ f32x4 mma16(bf16x8_t x, bf16x8_t y, f32x4 c) { return __builtin_amdgcn_mfma_f32_16x16x32_bf16(x, y, c, 0, 0, 0); }
constexpr int HG_LDK = 136, HG_LDS = 72;
constexpr int P1_QM = 0, P1_KM = 17408, P1_KLT = 34816, P1_VT = 53248, P1_AM = 71680, P1_TOT = 80896;
constexpr size_t WS_HD = 57 * MiB;
__device__ __forceinline__ void hgrn_pass1_unit(Frame& F, int unit) {
    const int bh = unit >> 7, c = unit & 127, b = bh >> 2, h = bh & 3; const size_t row0 = (size_t)b * SEQ + c * 64;
    float* LF = (float*)(F.ws + WS_LF); bf16* QO = (bf16*)(F.ws + WS_QO); const bf16* VH = (const bf16*)(F.ws + WS_VH);
    bf16* UT = (bf16*)F.out + (size_t)unit * 16384; float* HD = (float*)(F.ws + WS_HD) + (size_t)unit * 128;
    LAS bf16* Qm = (LAS bf16*)(F.lds + P1_QM); LAS bf16* Km = (LAS bf16*)(F.lds + P1_KM); LAS bf16* KlT = (LAS bf16*)(F.lds + P1_KLT); LAS bf16* VT = (LAS bf16*)(F.lds + P1_VT); LAS bf16* Am = (LAS bf16*)(F.lds + P1_AM);
    LAS float* tot = (LAS float*)(F.lds + P1_TOT);
    const int k = F.tid & 127, tq = F.tid >> 7, fr = F.lane & 15, fq = F.lane >> 4;
    float lf[16], g[16]; unsigned short qv[16], vv[16];
#pragma unroll
    for (int i = 0; i < 16; ++i) { const size_t r = row0 + 16 * tq + i; lf[i] = LF[r * 512 + h * 128 + k]; qv[i] = QO[r * DM + h * 128 + k]; vv[i] = VH[r * 512 + h * 128 + k]; }
    float run = 0.f;
#pragma unroll
    for (int i = 0; i < 16; ++i) { run += lf[i]; g[i] = run; }
    tot[tq * 128 + k] = run;
    { v4u w0, w1; w0.x = vv[0] | (vv[1] << 16); w0.y = vv[2] | (vv[3] << 16); w0.z = vv[4] | (vv[5] << 16); w0.w = vv[6] | (vv[7] << 16); w1.x = vv[8] | (vv[9] << 16); w1.y = vv[10] | (vv[11] << 16); w1.z = vv[12] | (vv[13] << 16); w1.w = vv[14] | (vv[15] << 16);
      *(LAS v4u*)(VT + k * HG_LDS + 16 * tq) = w0; *(LAS v4u*)(VT + k * HG_LDS + 16 * tq + 8) = w1; }
    __syncthreads();
    const float t0 = tot[k], t1 = tot[128 + k], t2 = tot[256 + k], t3 = tot[384 + k];
    const float off = (tq > 0 ? t0 : 0.f) + (tq > 1 ? t1 : 0.f) + (tq > 2 ? t2 : 0.f), gmid = t0 + t1, glast = gmid + t2 + t3;
    float kl[16];
#pragma unroll
    for (int i = 0; i < 16; ++i) { const size_t r = row0 + 16 * tq + i; const float gi = off + g[i], q = bf2f(qv[i]), kk = 1.f - __expf(lf[i]);
        QO[r * DM + h * 128 + k] = f2bf(q * __expf(gi));
        Qm[(16 * tq + i) * HG_LDK + k] = f2bf(q * __expf(fminf(gi - gmid, 80.f)));
        Km[(16 * tq + i) * HG_LDK + k] = f2bf(kk * __expf(fminf(gmid - gi, 80.f)));
        kl[i] = kk * __expf(glast - gi); }
    { v4u w0, w1; w0.x = cvt_pk_bf16(kl[0], kl[1]); w0.y = cvt_pk_bf16(kl[2], kl[3]); w0.z = cvt_pk_bf16(kl[4], kl[5]); w0.w = cvt_pk_bf16(kl[6], kl[7]); w1.x = cvt_pk_bf16(kl[8], kl[9]); w1.y = cvt_pk_bf16(kl[10], kl[11]); w1.z = cvt_pk_bf16(kl[12], kl[13]); w1.w = cvt_pk_bf16(kl[14], kl[15]);
      *(LAS v4u*)(KlT + k * HG_LDS + 16 * tq) = w0; *(LAS v4u*)(KlT + k * HG_LDS + 16 * tq + 8) = w1; }
    if (tq == 0) HD[k] = __expf(glast);
    __syncthreads();
#pragma unroll
    for (int it = 0; it < 2; ++it) { const int idx = F.wave + 8 * it, st = idx >> 2, tt = idx & 3; f32x4 a = {0.f, 0.f, 0.f, 0.f};
        if (st <= tt) {
#pragma unroll
            for (int kk = 0; kk < 4; ++kk) a = mma16(*(const LAS bf16x8_t*)(Km + (16 * st + fr) * HG_LDK + 8 * fq + 32 * kk), *(const LAS bf16x8_t*)(Qm + (16 * tt + fr) * HG_LDK + 8 * fq + 32 * kk), a);
        }
        const int s0 = 16 * st + 4 * fq, t = 16 * tt + fr;
#pragma unroll
        for (int j = 0; j < 4; ++j) a[j] = (s0 + j <= t) ? a[j] : 0.f;
        v2u w; w.x = cvt_pk_bf16(a[0], a[1]); w.y = cvt_pk_bf16(a[2], a[3]); *(LAS v2u*)(Am + t * HG_LDS + s0) = w; }
    { const bf16x8_t x0 = *(const LAS bf16x8_t*)(KlT + (16 * F.wave + fr) * HG_LDS + 8 * fq), x1 = *(const LAS bf16x8_t*)(KlT + (16 * F.wave + fr) * HG_LDS + 8 * fq + 32);
#pragma unroll
      for (int vt = 0; vt < 8; ++vt) { f32x4 a = {0.f, 0.f, 0.f, 0.f};
          a = mma16(x0, *(const LAS bf16x8_t*)(VT + (16 * vt + fr) * HG_LDS + 8 * fq), a); a = mma16(x1, *(const LAS bf16x8_t*)(VT + (16 * vt + fr) * HG_LDS + 8 * fq + 32), a);
          v2u w; w.x = cvt_pk_bf16(a[0], a[1]); w.y = cvt_pk_bf16(a[2], a[3]); *(v2u*)(UT + (16 * vt + fr) * 128 + 16 * F.wave + 4 * fq) = w; } }
    __syncthreads();
    { const bf16x8_t x0 = *(const LAS bf16x8_t*)(VT + (16 * F.wave + fr) * HG_LDS + 8 * fq), x1 = *(const LAS bf16x8_t*)(VT + (16 * F.wave + fr) * HG_LDS + 8 * fq + 32);
#pragma unroll
      for (int tt = 0; tt < 4; ++tt) { f32x4 a = {0.f, 0.f, 0.f, 0.f};
          a = mma16(x0, *(const LAS bf16x8_t*)(Am + (16 * tt + fr) * HG_LDS + 8 * fq), a); a = mma16(x1, *(const LAS bf16x8_t*)(Am + (16 * tt + fr) * HG_LDS + 8 * fq + 32), a);
          v2u w; w.x = cvt_pk_bf16(a[0], a[1]); w.y = cvt_pk_bf16(a[2], a[3]); *(v2u*)((bf16*)F.out + (size_t)16 * 1024 * 1024 + (row0 + 16 * tt + fr) * 512 + h * 128 + 16 * F.wave + 4 * fq) = w; } }
    __syncthreads();
}
__device__ __forceinline__ void hgrn_pass2(Frame& F) {
    if (F.tid >= 256) return;
    for (int item = F.vcu * 256 + F.tid; item < 8 * 128 * 64; item += F.G * 256) {
        const int bh = item >> 13, rem = item & 8191;
        unsigned* up = (unsigned*)((bf16*)F.out + (size_t)bh * 128 * 16384) + rem; const float2* dp = (const float2*)((const float*)(F.ws + WS_HD) + (size_t)bh * 128 * 128) + (rem & 63);
        float s0 = 0.f, s1 = 0.f;
#pragma unroll 32
        for (int c = 0; c < 128; ++c) { const unsigned u = up[(size_t)c * 8192]; const float2 d = dp[c * 64];
            up[(size_t)c * 8192] = cvt_pk_bf16(s0, s1);
            s0 = d.x * s0 + bflo(u); s1 = d.y * s1 + bfhi(u); }
    }
}
__device__ __forceinline__ void hgrn_pass3_unit(Frame& F, const float* onw, int pu) {
    const int unit0 = 2 * pu, fr = F.lane & 15, fq = F.lane >> 4;
    const bf16* UT = (const bf16*)F.out + (size_t)unit0 * 16384; const float* LF = (const float*)(F.ws + WS_LF); bf16* QO = (bf16*)(F.ws + WS_QO); const bf16* GH = (const bf16*)(F.ws + WS_GH);
#pragma unroll
    for (int i = 0; i < 8; ++i) { const int p = F.tid + 512 * i, cc = p >> 11, q = p & 2047, v = q >> 4, c8 = q & 15;
        *(LAS v4u*)(F.lds + cc * 34816 + v * 272 + c8 * 16) = *(const v4u*)(UT + (size_t)cc * 16384 + v * 128 + c8 * 8); }
    __syncthreads();
    const int cc = F.wave >> 2, tt = F.wave & 3, unit = unit0 + cc, bh = unit >> 7, c = unit & 127, b = bh >> 2, h = bh & 3;
    const size_t row = (size_t)b * SEQ + c * 64 + 16 * tt + fr;
    bf16x8_t yq[4];
#pragma unroll
    for (int kk = 0; kk < 4; ++kk) yq[kk] = *(const bf16x8_t*)(QO + row * DM + h * 128 + 8 * fq + 32 * kk);
    f32x4 o[8]; float ss = 0.f;
#pragma unroll
    for (int vt = 0; vt < 8; ++vt) { const v2u oi = *(const v2u*)((const bf16*)F.out + (size_t)16 * 1024 * 1024 + row * 512 + h * 128 + 16 * vt + 4 * fq); f32x4 a; a[0] = bflo(oi.x); a[1] = bfhi(oi.x); a[2] = bflo(oi.y); a[3] = bfhi(oi.y);
#pragma unroll
        for (int kk = 0; kk < 4; ++kk) a = mma16(*(const LAS bf16x8_t*)(F.lds + cc * 34816 + (16 * vt + fr) * 272 + (8 * fq + 32 * kk) * 2), yq[kk], a);
        o[vt] = a; ss += (a[0] * a[0] + a[1] * a[1]) + (a[2] * a[2] + a[3] * a[3]); }
    ss += __shfl_xor(ss, 16); ss += __shfl_xor(ss, 32);
    const float rs = __builtin_amdgcn_rsqf(ss * (1.f / 128.f) + EPS);
#pragma unroll
    for (int vt = 0; vt < 8; ++vt) { const int v0 = 16 * vt + 4 * fq; const f32x4 w4 = *(const f32x4*)(onw + v0); const v2u gt = *(const v2u*)(GH + row * 512 + h * 128 + v0);
        v2u w; w.x = cvt_pk_bf16(o[vt][0] * rs * w4[0] * bflo(gt.x), o[vt][1] * rs * w4[1] * bfhi(gt.x)); w.y = cvt_pk_bf16(o[vt][2] * rs * w4[2] * bflo(gt.y), o[vt][3] * rs * w4[3] * bfhi(gt.y));
        *(v2u*)(QO + row * DM + h * 128 + v0) = w; }
    __syncthreads();
}
__device__ __forceinline__ void final_norm(Frame& F, const float* w) {
    const int gw = F.vcu * NWAVES + F.wave, NGW = F.G * NWAVES; const float* ssq = (const float*)(F.ws + WS_SSQ); const bf16* XBp = (const bf16*)(F.ws + WS_XB);
    f32x4 wv[4];
#pragma unroll
    for (int j = 0; j < 4; ++j) wv[j] = ((const f32x4*)w + F.lane)[64 * j];
    for (int m = gw; m < M; m += 2 * NGW) {
        const int m1 = m + NGW; const bool two = m1 < M; const int mb = two ? m1 : m;
        float s0 = (F.lane < 16) ? ssq[(size_t)m * 16 + F.lane] : 0.f, s1 = (F.lane < 16) ? ssq[(size_t)mb * 16 + F.lane] : 0.f;
        const v2u* x0 = (const v2u*)(XBp + (size_t)m * DM) + F.lane; const v2u* x1 = (const v2u*)(XBp + (size_t)mb * DM) + F.lane;
        v2u b0[4], b1[4];
#pragma unroll
        for (int j = 0; j < 4; ++j) { b0[j] = x0[64 * j]; b1[j] = x1[64 * j]; }
        s0 = wave_sum(s0); s1 = wave_sum(s1);
        const float r0 = __builtin_amdgcn_rsqf(s0 * (1.f / DM) + EPS), r1 = __builtin_amdgcn_rsqf(s1 * (1.f / DM) + EPS);
        f32x4* o0 = (f32x4*)(F.out + (size_t)m * DM) + F.lane; f32x4* o1 = (f32x4*)(F.out + (size_t)mb * DM) + F.lane;
#pragma unroll
        for (int j = 0; j < 4; ++j) { f32x4 v; v[0] = bflo(b0[j].x); v[1] = bfhi(b0[j].x); v[2] = bflo(b0[j].y); v[3] = bfhi(b0[j].y); o0[64 * j] = v * r0 * wv[j]; }
        if (two) {
#pragma unroll
            for (int j = 0; j < 4; ++j) { f32x4 v; v[0] = bflo(b1[j].x); v[1] = bfhi(b1[j].x); v[2] = bflo(b1[j].y); v[3] = bfhi(b1[j].y); o1[64 * j] = v * r1 * wv[j]; } }
    }
}
#define RLX_AGENT __ATOMIC_RELAXED, __HIP_MEMORY_SCOPE_AGENT
#define XB_TMO      128
#define XB_XCNT(j)  (256  + 64 * (j))
#define XB_XSUB(j)  (1280 + 64 * (j))
#define XB_XGEN(j)  (2304 + 64 * (j))
#define XB_TOP      3328
#define XB_TOPGEN   3392
#define XB_SPIN_CAP (1u << 22)
__device__ __forceinline__ unsigned xb_ld_u(unsigned* p) { return (unsigned)__builtin_amdgcn_readfirstlane((int)__hip_atomic_load(p, RLX_AGENT)); }
__device__ __forceinline__ unsigned xb_add_u(unsigned* p, unsigned v, int lane) { unsigned r = 0u; if (lane == 0) r = __hip_atomic_fetch_add(p, v, RLX_AGENT); return (unsigned)__builtin_amdgcn_readfirstlane((int)r); }
__device__ __forceinline__ unsigned xb_xcc_id() { return (unsigned)__builtin_amdgcn_s_getreg((3 << 11) | 20) & 0xFu; }
#define XB_SPIN_U(cond, bar) do { unsigned _sp = 0; while (cond) { __builtin_amdgcn_s_sleep(1); if (++_sp > XB_SPIN_CAP) { if (lane == 0) atomicAdd(&(bar)[XB_TMO], 1u); break; } } } while (0)
__device__ __forceinline__ void xcd_barrier(unsigned* bar, volatile __attribute__((address_space(3))) unsigned* st, int wave, int lane) {
    asm volatile("s_waitcnt vmcnt(0)" ::: "memory");
    __syncthreads();
    if (wave == 0) {
        __builtin_amdgcn_s_waitcnt(0);
        const unsigned x = xb_xcc_id();
        unsigned nloc = (unsigned)__builtin_amdgcn_readfirstlane((int)st[0]), nx = (unsigned)__builtin_amdgcn_readfirstlane((int)st[1]);
        if (nloc == 0u) {
            const unsigned G = gridDim.x; unsigned sp = 0u;
            (void)xb_add_u(&bar[XB_XCNT(x)], 1u, lane);
            for (;;) { unsigned sum = 0u, cnt = 0u, mine = 0u;
#pragma unroll
                for (unsigned j = 0; j < 16; ++j) { const unsigned c = xb_ld_u(&bar[XB_XCNT(j)]); sum += c; cnt += (c > 0u) ? 1u : 0u; mine = (j == x) ? c : mine; }
                nloc = mine > 0u ? mine : 1u; nx = cnt > 0u ? cnt : 1u;
                if (sum == G) break;
                __builtin_amdgcn_s_sleep(1);
                if (++sp > XB_SPIN_CAP) { if (lane == 0) atomicAdd(&bar[XB_TMO], 1u); break; } }
            if (lane == 0) { st[0] = nloc; st[1] = nx; }
        }
        const unsigned old = xb_add_u(&bar[XB_XSUB(x)], 1u, lane), gen = old / nloc;
        if (old + 1u == (gen + 1u) * nloc) {
            __builtin_amdgcn_fence(__ATOMIC_RELEASE, "agent");
            asm volatile("s_waitcnt vmcnt(0)" ::: "memory");
            const unsigned og = xb_add_u(&bar[XB_TOP], 1u, lane), tg = og / nx;
            if (og + 1u == (tg + 1u) * nx) (void)xb_add_u(&bar[XB_TOPGEN], 1u, lane);
            else XB_SPIN_U(xb_ld_u(&bar[XB_TOPGEN]) == tg, bar);
            __builtin_amdgcn_fence(__ATOMIC_ACQUIRE, "agent");
            (void)xb_add_u(&bar[XB_XGEN(x)], 1u, lane);
            asm volatile("s_waitcnt vmcnt(0)" ::: "memory");
        } else {
            XB_SPIN_U(xb_ld_u(&bar[XB_XGEN(x)]) == gen, bar);
            __builtin_amdgcn_fence(__ATOMIC_ACQUIRE, "agent");
            asm volatile("s_waitcnt vmcnt(0)" ::: "memory");
        }
    }
    __syncthreads();
}

constexpr size_t WS_CTL = 226 * MiB, CTL_BYTES = 65536, WS_END3 = 227 * MiB;
constexpr int LDS_MISC = 139264;
template <class T> __device__ __forceinline__ T* uni_ptr(T* p) { const unsigned long long v = (unsigned long long)p; const unsigned lo = __builtin_amdgcn_readfirstlane((unsigned)v), hi = __builtin_amdgcn_readfirstlane((unsigned)(v >> 32)); return (T*)(((unsigned long long)hi << 32) | lo); }
__global__ void __launch_bounds__(NTHREADS, 2) mega_fwd(Args args) {
    extern __shared__ __attribute__((aligned(16))) unsigned char lds[];
    cg::grid_group grid = cg::this_grid();
    #define PHASE_PTRS int bx_ = blockIdx.x; asm volatile("" : "+s"(bx_)); int G_ = gridDim.x; asm volatile("" : "+s"(G_)); (void)bx_; (void)G_; LAS unsigned char* ldsp = (LAS unsigned char*)lds; asm volatile("" : "+s"(ldsp)); (void)ldsp; unsigned char* ws = args.ws; asm volatile("" : "+s"(ws)); float* outp = args.out; asm volatile("" : "+s"(outp)); bf16* XB = (bf16*)(ws + WS_XB); float* SSQ = (float*)(ws + WS_SSQ); bf16* ACT = (bf16*)(ws + WS_ACT); (void)XB; (void)SSQ; (void)ACT; (void)outp;
#define MKFRAME Frame F; { int t_ = threadIdx.x; asm volatile("" : "+v"(t_)); F.lds = ldsp; F.tid = t_; F.lane = t_ & 63; F.wave = __builtin_amdgcn_readfirstlane(t_ >> 6); F.G = G_; F.vcu = (G_ % 8 == 0) ? (bx_ % 8) * (G_ / 8) + bx_ / 8 : bx_; F.ws = ws; F.out = outp; }
#define GSYNC() do { LAS unsigned char* l_ = (LAS unsigned char*)lds; asm volatile("" : "+s"(l_)); unsigned char* w_ = args.ws; asm volatile("" : "+s"(w_)); int t_ = threadIdx.x; asm volatile("" : "+v"(t_)); xcd_barrier((unsigned*)(w_ + WS_CTL), (volatile LAS unsigned*)(l_ + LDS_MISC), __builtin_amdgcn_readfirstlane(t_ >> 6), t_ & 63); } while (0)
    if (threadIdx.x < 16) ((volatile LAS unsigned*)((LAS unsigned char*)lds + LDS_MISC))[threadIdx.x] = 0u;
    __syncthreads();
    for (int l = 0; l < DEPTH; ++l) {
#ifndef NO_PRO
        { PHASE_PTRS MKFRAME
        prologue(F, args, l); }
#endif
        if (gridDim.y > 1) grid.sync(); else GSYNC();
        {   PHASE_PTRS
            pg8::Gemm g{XB, (const bf16*)(ws + WS_W1A), M, 2 * FFH, DM, DM, DM}; pg8::StaticOrder S; S.init(M, 2 * FFH, G_, bx_);
            EpiSwiglu E{ACT, SSQ};
            pg8::gemm_phase<EpiSwiglu, pg8::StaticOrder, true, true>(ldsp, g, S, E);
            pg8::Gemm g2{(const bf16*)(ws + WS_MEMN), (const bf16*)(ws + WS_WKV), MROWS, 2 * DM, DM, DM, DM}; pg8::StaticOrder S2; S2.init(MROWS, 2 * DM, G_, bx_ >= 128 ? bx_ - 128 : (1 << 28));
            EpiPlain E2{(bf16*)(ws + WS_KV), 2 * DM, nullptr, 1.f};
            pg8::gemm_phase<EpiPlain, pg8::StaticOrder, true, true>(ldsp, g2, S2, E2);
        }
        GSYNC();
        {   PHASE_PTRS
            pg8::Gemm g{ACT, (const bf16*)(ws + WS_W1B), M, DM, FFH, FFH, FFH}; pg8::StaticOrder S; S.init(M, DM, G_, bx_);
            EpiRes E{XB, SSQ, 0.5f};
            pg8::gemm_phase<EpiRes, pg8::StaticOrder, true, true>(ldsp, g, S, E);
        }
        GSYNC();
        {   PHASE_PTRS
            pg8::Gemm g{XB, (const bf16*)(ws + WS_WIN), M, NINP, DM, DM, DM}; pg8::StaticOrder S; S.init(M, NINP, G_, bx_);
            EpiWin E{ws, (const float*)(ws + WS_LB) + l * 512, args.in[10] + l * 8};
            pg8::gemm_phase<EpiWin, pg8::StaticOrder, true, true>(ldsp, g, S, E);
        }
        {   PHASE_PTRS
            int kf_ = 256; asm volatile("" : "+s"(kf_));
            { pg8::Gemm gA{(const bf16*)(ws + WS_KV), (const bf16*)(ws + WS_WQ), 256, 256, kf_, 2 * DM, DM}; pg8::FoldOrder SA{bx_ - 192, false}; EpiFold EA{(bf16*)(ws + WS_WQK), false, 0.0625f};
              pg8::gemm_phase<EpiFold, pg8::FoldOrder, true, true>(ldsp, gA, SA, EA); }
            { pg8::Gemm gB{(const bf16*)(ws + WS_WO), (const bf16*)(ws + WS_KV), 256, 256, kf_, DM, 2 * DM}; pg8::FoldOrder SB{bx_ - 224, true}; EpiFold EB{(bf16*)(ws + WS_VWO), true, 1.f};
              pg8::gemm_phase<EpiFold, pg8::FoldOrder, true, true>(ldsp, gB, SB, EB); }
        }
        GSYNC();
        { PHASE_PTRS MKFRAME
          for (int u = F.vcu; u < 1024 + 16; u += F.G) { if (u < 1024) hgrn_pass1_unit(F, u); else fox_cumsum_unit(F, u - 1024); } }
        GSYNC();
        { PHASE_PTRS MKFRAME fox_bounds(F); hgrn_pass2(F); }
        GSYNC();
        { PHASE_PTRS MKFRAME for (int u = F.vcu; u < 512; u += F.G) hgrn_pass3_unit(F, args.in[9] + l * 128, u); }
        {   PHASE_PTRS
            const attn_body::AttnTensors AT{(const attn_body::bf16*)(ws + WS_QO) + 512, (const attn_body::bf16*)(ws + WS_FK), (const attn_body::bf16*)(ws + WS_FV), (attn_body::bf16*)(ws + WS_QO) + 512, (const float*)(ws + WS_C2), (const float*)(ws + WS_KMAX), (const float*)(ws + WS_QS)};
            const attn_body::StaticOrder S(G_, bx_, (const int*)(ws + WS_ORD));
            attn_body::attn_phase<attn_body::StaticOrder>((char*)ldsp, AT, S);
        }
        GSYNC();
        {   PHASE_PTRS
            pg8::Gemm g{(const bf16*)(ws + WS_QO), (const bf16*)(ws + WS_WOUT), M, DM, DM, DM, DM}; pg8::StaticOrder S; S.init(M, DM, G_, bx_);
            EpiRes E{XB, SSQ, 1.0f};
            pg8::gemm_phase<EpiRes, pg8::StaticOrder, true, true>(ldsp, g, S, E);
        }
        GSYNC();
        {   PHASE_PTRS
            pg8::Gemm g{XB, (const bf16*)(ws + WS_WQK), M, DM, DM, DM, DM}; pg8::BatchOrder S; S.init(M, DM, G_, bx_); S.mb = SEQ / 256; S.bstride = (size_t)DM * DM * 2;
            EpiSoftmax E{(bf16*)(ws + WS_PB), SSQ, (LAS float*)(ldsp + 131072)};
            pg8::gemm_phase<EpiSoftmax, pg8::BatchOrder, true, true>(ldsp, g, S, E);
        }
        GSYNC();
        {   PHASE_PTRS
            pg8::Gemm g{(const bf16*)(ws + WS_PB), (const bf16*)(ws + WS_VWO), M, DM, DM, DM, DM}; pg8::BatchOrder S; S.init(M, DM, G_, bx_); S.mb = SEQ / 256; S.bstride = (size_t)DM * DM * 2;
            EpiRes E{XB, SSQ, 1.0f};
            pg8::gemm_phase<EpiRes, pg8::BatchOrder, true, true>(ldsp, g, S, E);
        }
        GSYNC();
        {   PHASE_PTRS
            pg8::Gemm g{XB, (const bf16*)(ws + WS_W2A), M, 2 * FFH, DM, DM, DM}; pg8::StaticOrder S; S.init(M, 2 * FFH, G_, bx_);
            EpiSwiglu E{ACT, SSQ};
            pg8::gemm_phase<EpiSwiglu, pg8::StaticOrder, true, true>(ldsp, g, S, E);
        }
        GSYNC();
        {   PHASE_PTRS
            pg8::Gemm g{ACT, (const bf16*)(ws + WS_W2B), M, DM, FFH, FFH, FFH}; pg8::StaticOrder S; S.init(M, DM, G_, bx_);
            EpiRes E{XB, SSQ, 0.5f};
            pg8::gemm_phase<EpiRes, pg8::StaticOrder, true, true>(ldsp, g, S, E);
        }
        GSYNC();
    }
    { PHASE_PTRS MKFRAME
    final_norm(F, args.in[22]); }
}

extern "C" void kernel_launch(void* const* d_in, const int* in_sizes, int n_in, void* d_out, int out_size, void* d_ws, size_t ws_size, hipStream_t stream) {
    static int grid = 0;
    if (grid == 0) {
        if (n_in != 23 || out_size != M * DM || ws_size < WS_END3) { fprintf(stderr, "kernel_launch: unexpected shapes n_in %d out %d ws %zu\n", n_in, out_size, ws_size); grid = -1; return; }
        int dev = 0, cus = 0, per_cu = 0;
        hipGetDevice(&dev); hipDeviceGetAttribute(&cus, hipDeviceAttributeMultiprocessorCount, dev);
        hipFuncSetAttribute((const void*)mega_fwd, hipFuncAttributeMaxDynamicSharedMemorySize, LDS_BYTES);
        hipOccupancyMaxActiveBlocksPerMultiprocessor(&per_cu, (const void*)mega_fwd, NTHREADS, LDS_BYTES);
        (void)hipGetLastError();
        if (per_cu < 1) per_cu = 1;
        grid = cus;
    }
    if (grid < 0) return;
    if (hipMemsetAsync((char*)d_ws + WS_CTL, 0, CTL_BYTES, stream) != hipSuccess) { fprintf(stderr, "kernel_launch: memset of the barrier words failed\n"); return; }
    Args a{};
    for (int i = 0; i < 23; ++i) a.in[i] = (const float*)d_in[i];
    a.out = (float*)d_out; a.ws = (unsigned char*)d_ws;
    void* kargs[] = {&a};
    hipError_t e = hipLaunchCooperativeKernel((const void*)mega_fwd, dim3(grid), dim3(NTHREADS), kargs, LDS_BYTES, stream);
    if (e != hipSuccess) fprintf(stderr, "cooperative launch failed: %s (grid %d)\n", hipGetErrorString(e), grid);
}
```

```cpp
#include <hip/hip_runtime.h>
#include <hip/hip_cooperative_groups.h>
#include <cstdio>
#include <cstdint>
namespace cg = cooperative_groups;
namespace pg8 {
#define PG8_LAS __attribute__((address_space(3)))
typedef unsigned short bf16_t;
typedef short bf16x8 __attribute__((ext_vector_type(8)));
typedef float f32x4 __attribute__((ext_vector_type(4)));
typedef unsigned u32x4 __attribute__((ext_vector_type(4)));
constexpr int BM = 256, BK = 64, HALF = 128, HTB = HALF * BK * 2  , STAGE_BYTES = 8 * HTB, NXCD = 8, WGM = 8;

__host__ __device__ __forceinline__ int lds_byte(int r, int c) { const int st = (r >> 4) * 2 + (c >> 5), rr = r & 15, cc = c & 31, ob = rr * 64 + cc * 2; return st * 1024 + (ob ^ (((ob >> 9) & 1) << 5)); }
__host__ __device__ __forceinline__ void stage_rc(int b, int& R, int& C) { const int st = b / 1024, sb = b % 1024, swz = sb ^ (((sb >> 9) & 1) << 5); R = (st >> 1) * 16 + swz / 64; C = (st & 1) * 32 + (swz % 64) / 2; }
__host__ __device__ __forceinline__ int perm32(int rho) { const int n = rho >> 4, i = rho & 15; return 8 * (i >> 2) + 4 * n + (i & 3); }

struct Unit { int pm, pn; };
struct Gemm { const bf16_t* A; const bf16_t* Bt; int M, N, K, lda, ldb; };

struct StaticOrder {
    int nM, nN, nwg, G, c;
    __host__ __device__ void init(int M, int N, int G_, int c_) { nM = M / BM; nN = N / BM; nwg = nM * nN; G = G_; c = c_; }
    __host__ __device__ bool next(int i, Unit& u) const {
        const long L = (long)i * G + c; if (L >= nwg) return false;
        int wgid = (int)L; { const int q = nwg / NXCD, r = nwg % NXCD, xcd = wgid % NXCD, off = wgid / NXCD; wgid = (xcd < r ? xcd * (q + 1) : r * (q + 1) + (xcd - r) * q) + off; }
        const int nig = WGM * nN, gid = wgid / nig, fm = gid * WGM, gsz = (nM - fm) < WGM ? (nM - fm) : WGM;
        u.pm = fm + ((wgid % nig) % gsz); u.pn = (wgid % nig) / gsz; return true;
    }
    __device__ __forceinline__ void a_ready(const Unit&) const {}
    __device__ __forceinline__ void done(const Unit&) const {}
    __device__ __forceinline__ size_t aoff(const Unit& u, size_t tstep) const { return (size_t)u.pm * tstep; }
    __device__ __forceinline__ size_t boff(const Unit& u, size_t tstep) const { return (size_t)u.pn * tstep; }
};
struct BatchOrder : StaticOrder { int mb; size_t bstride;
    __device__ __forceinline__ size_t boff(const Unit& u, size_t tstep) const { return (size_t)u.pn * tstep + (u.pm >= mb ? bstride : 0); } };
struct FoldOrder { int j; bool modeB;
    __device__ __forceinline__ bool next(int i, Unit& u) const { if (i > 0 || j < 0 || j >= 32) return false; u.pm = j; u.pn = 0; return true; }
    __device__ __forceinline__ void a_ready(const Unit&) const {}
    __device__ __forceinline__ void done(const Unit&) const {}
    __device__ __forceinline__ size_t aoff(const Unit& u, size_t) const { const int hd = u.pm >> 3, b = (u.pm >> 2) & 1, q = u.pm & 3; return modeB ? ((size_t)q * 256 * 1024 + hd * 256) * 2 : ((size_t)b * 256 * 2048 + hd * 256) * 2; }
    __device__ __forceinline__ size_t boff(const Unit& u, size_t) const { const int hd = u.pm >> 3, b = (u.pm >> 2) & 1, q = u.pm & 3; return modeB ? ((size_t)b * 256 * 2048 + 1024 + hd * 256) * 2 : ((size_t)q * 256 * 1024 + hd * 256) * 2; }
};

typedef float f32x2cv __attribute__((ext_vector_type(2))); typedef __bf16 bf16x2cv __attribute__((ext_vector_type(2)));
__device__ __forceinline__ unsigned cvt_pk_bf16(float lo, float hi) { const f32x2cv v = {lo, hi}; const bf16x2cv b = __builtin_convertvector(v, bf16x2cv); return __builtin_bit_cast(unsigned, b); }
template <class Epi, class Sched, bool ALIGN_EPI = false, bool SP2 = false>
__device__ __forceinline__ void gemm_phase(PG8_LAS unsigned char* lds, const Gemm g, const Sched& S, const Epi& E) {
    int tid_ = threadIdx.x; asm volatile("" : "+v"(tid_)); const int tid = tid_, wid = __builtin_amdgcn_readfirstlane(tid >> 6), lane = tid & 63, wr = wid >> 2, wc = wid & 3, fr = lane & 15, fq = lane >> 4;
    const int K = g.K, nt = K / BK;
    unsigned voffA[2], voffB[2];
#pragma unroll
    for (int i = 0; i < 2; ++i) { int R, C; stage_rc(tid * 16 + i * 8192, R, C); const int Rb = Epi::PERM ? ((R & ~31) + perm32(R & 31)) : R;
        voffA[i] = (unsigned)(R * g.lda + C) * 2u; voffB[i] = (unsigned)(Rb * g.ldb + C) * 2u; }
    const size_t kstep = (size_t)(BK * 2);
    const size_t hstepA = (size_t)HALF * g.lda * 2, hstepB = (size_t)HALF * g.ldb * 2;
    const size_t tstepA = 2 * hstepA, tstepB = 2 * hstepB;
    const unsigned ldsw = (unsigned)wid * 1024u;
    const int aoff = lds_byte(wr * 64 + fr, fq * 8), boff = lds_byte(wc * 32 + fr, fq * 8);
#define PG8_SA(b, h) (((b) * 2 + (h)) * HTB)
#define PG8_SB(b, h) ((4 + (b) * 2 + (h)) * HTB)
#define PG8_STAGE(bufoff, gbase, voff) do { _Pragma("unroll") for (int _i = 0; _i < 2; ++_i) \
        __builtin_amdgcn_global_load_lds((const unsigned*)((const char*)(gbase) + (voff)[_i]), (PG8_LAS unsigned*)(lds + (bufoff) + ldsw + _i * 8192), 16, 0, 0); } while (0)
#define PG8_LDA(dst, b, h) do { _Pragma("unroll") for (int m = 0; m < 4; ++m) _Pragma("unroll") for (int k = 0; k < 2; ++k) dst[m][k] = *(const PG8_LAS bf16x8*)(lds + PG8_SA(b, h) + aoff + m * 2048 + k * 1024); } while (0)
#define PG8_LDB(dst, b, h) do { _Pragma("unroll") for (int n = 0; n < 2; ++n) _Pragma("unroll") for (int k = 0; k < 2; ++k) dst[n][k] = *(const PG8_LAS bf16x8*)(lds + PG8_SB(b, h) + boff + n * 2048 + k * 1024); } while (0)
#define PG8_MMA(ai, bj, At, Bt) do { __builtin_amdgcn_s_setprio(1); _Pragma("unroll") for (int m = 0; m < 4; ++m) _Pragma("unroll") for (int n = 0; n < 2; ++n) _Pragma("unroll") for (int k = 0; k < 2; ++k) \
        acc[ai][bj][m][n] = __builtin_amdgcn_mfma_f32_16x16x32_bf16(Bt[n][k], At[m][k], acc[ai][bj][m][n], 0, 0, 0); __builtin_amdgcn_s_setprio(0); } while (0)
#define PG8_WAIT_V(n) asm volatile("s_waitcnt vmcnt(" #n ")" ::: "memory")
#define PG8_WAIT_L(n) asm volatile("s_waitcnt lgkmcnt(" #n ")" ::: "memory")
#define PG8_BAR __builtin_amdgcn_s_barrier()
#define PG8_SCHED __builtin_amdgcn_sched_barrier(0)
    Unit cur, nxt; int ui = 0;
    if (!S.next(0, cur)) return;
    f32x4 acc[2][2][4][2];
#pragma unroll
    for (int a = 0; a < 2; ++a)
#pragma unroll
        for (int b = 0; b < 2; ++b)
#pragma unroll
            for (int m = 0; m < 4; ++m)
#pragma unroll
                for (int n = 0; n < 2; ++n) acc[a][b][m][n] = (f32x4){0.f, 0.f, 0.f, 0.f};
    bf16x8 At[4][2], B0[2][2], B1[2][2];
    const char* cA = (const char*)g.A + S.aoff(cur, tstepA); const char* cB = (const char*)g.Bt + S.boff(cur, tstepB);
    S.a_ready(cur);
    if constexpr (SP2) {
        PG8_STAGE(PG8_SB(0, 0), cB, voffB); PG8_STAGE(PG8_SB(0, 1), cB + hstepB, voffB); PG8_STAGE(PG8_SA(0, 0), cA, voffA); PG8_STAGE(PG8_SA(0, 1), cA + hstepA, voffA);
        if (wr == 1) PG8_BAR;
        PG8_WAIT_V(2); PG8_BAR;
        PG8_STAGE(PG8_SB(1, 0), cB + kstep, voffB); PG8_STAGE(PG8_SA(1, 0), cA + kstep, voffA); PG8_STAGE(PG8_SB(1, 1), cB + hstepB + kstep, voffB);
        PG8_WAIT_V(6); PG8_BAR;
    } else {
        PG8_STAGE(PG8_SB(0, 0), cB, voffB); PG8_STAGE(PG8_SA(0, 0), cA, voffA); PG8_STAGE(PG8_SB(0, 1), cB + hstepB, voffB); PG8_STAGE(PG8_SA(0, 1), cA + hstepA, voffA);
        if (wr == 1) PG8_BAR;
        PG8_WAIT_V(4); PG8_BAR;
        PG8_STAGE(PG8_SB(1, 0), cB + kstep, voffB); PG8_STAGE(PG8_SA(1, 0), cA + kstep, voffA); PG8_STAGE(PG8_SB(1, 1), cB + hstepB + kstep, voffB);
        PG8_WAIT_V(6); PG8_BAR;
    }
    for (;;) {
        const bool has_next = S.next(ui + 1, nxt);
        const char* nA = has_next ? (const char*)g.A + S.aoff(nxt, tstepA) : cA; const char* nB = has_next ? (const char*)g.Bt + S.boff(nxt, tstepB) : cB;
        for (int t = 0; t < nt; t += 2) {
            const bool last = (t == nt - 2);
            const char* a1 = cA + (size_t)(t + 1) * kstep;
            const char* a2 = last ? nA : cA + (size_t)(t + 2) * kstep; const char* b2 = last ? nB : cB + (size_t)(t + 2) * kstep;
            const char* a3 = a2 + kstep; const char* b3 = b2 + kstep;
            if (last && has_next) S.a_ready(nxt);
            if constexpr (SP2) {
            PG8_LDB(B0, 0, 0); PG8_LDB(B1, 0, 1); PG8_SCHED; PG8_LDA(At, 0, 0); PG8_STAGE(PG8_SA(1, 1), a1 + hstepA, voffA);
            PG8_WAIT_V(8); PG8_WAIT_L(0); PG8_BAR; PG8_MMA(0, 0, At, B0); PG8_MMA(0, 1, At, B1); PG8_BAR; PG8_SCHED;
            PG8_LDA(At, 0, 1); PG8_STAGE(PG8_SB(0, 0), b2, voffB); PG8_STAGE(PG8_SB(0, 1), b2 + hstepB, voffB); PG8_STAGE(PG8_SA(0, 0), a2, voffA);
            PG8_WAIT_V(8); PG8_WAIT_L(0); PG8_BAR; PG8_MMA(1, 0, At, B0); PG8_MMA(1, 1, At, B1); PG8_BAR; PG8_SCHED;
            PG8_LDB(B0, 1, 0); PG8_LDB(B1, 1, 1); PG8_SCHED; PG8_LDA(At, 1, 0); PG8_STAGE(PG8_SA(0, 1), a2 + hstepA, voffA);
            PG8_WAIT_V(8); PG8_WAIT_L(0); PG8_BAR; PG8_MMA(0, 0, At, B0); PG8_MMA(0, 1, At, B1); PG8_BAR; PG8_SCHED;
            PG8_LDA(At, 1, 1); PG8_STAGE(PG8_SB(1, 0), b3, voffB); PG8_STAGE(PG8_SB(1, 1), b3 + hstepB, voffB); PG8_STAGE(PG8_SA(1, 0), a3, voffA);
            PG8_WAIT_V(8); PG8_WAIT_L(0); PG8_BAR; PG8_MMA(1, 0, At, B0); PG8_MMA(1, 1, At, B1); PG8_BAR; PG8_SCHED;
            } else {
            PG8_LDB(B0, 0, 0); PG8_SCHED; PG8_LDA(At, 0, 0); PG8_STAGE(PG8_SA(1, 1), a1 + hstepA, voffA);
            PG8_WAIT_L(8); PG8_BAR; PG8_WAIT_L(0); PG8_MMA(0, 0, At, B0); PG8_BAR; PG8_SCHED;
            PG8_LDB(B1, 0, 1); PG8_STAGE(PG8_SB(0, 0), b2, voffB);
            PG8_BAR; PG8_WAIT_L(0); PG8_MMA(0, 1, At, B1); PG8_BAR;
            PG8_LDA(At, 0, 1); PG8_STAGE(PG8_SA(0, 0), a2, voffA);
            PG8_BAR; PG8_WAIT_L(0); PG8_MMA(1, 0, At, B0); PG8_BAR; PG8_SCHED;
            PG8_STAGE(PG8_SB(0, 1), b2 + hstepB, voffB);
            PG8_WAIT_V(6); PG8_BAR; PG8_MMA(1, 1, At, B1); PG8_BAR;
            PG8_LDB(B0, 1, 0); PG8_SCHED; PG8_LDA(At, 1, 0); PG8_STAGE(PG8_SA(0, 1), a2 + hstepA, voffA);
            PG8_WAIT_L(8); PG8_BAR; PG8_WAIT_L(0); PG8_MMA(0, 0, At, B0); PG8_BAR; PG8_SCHED;
            PG8_LDB(B1, 1, 1); PG8_STAGE(PG8_SB(1, 0), b3, voffB);
            PG8_BAR; PG8_WAIT_L(0); PG8_MMA(0, 1, At, B1); PG8_BAR;
            PG8_LDA(At, 1, 1); PG8_STAGE(PG8_SA(1, 0), a3, voffA);
            PG8_BAR; PG8_WAIT_L(0); PG8_MMA(1, 0, At, B0); PG8_BAR; PG8_SCHED;
            PG8_STAGE(PG8_SB(1, 1), b3 + hstepB, voffB);
            PG8_WAIT_V(6); PG8_BAR; PG8_MMA(1, 1, At, B1); PG8_BAR;
            }
        }
        if constexpr (ALIGN_EPI) { if (wr == 0) PG8_BAR; }
        if constexpr (!Epi::AFTER_DRAIN) { E(acc, cur, wr, wc, fr, fq); S.done(cur); }
        if (!has_next) break;
#pragma unroll
        for (int a = 0; a < 2; ++a)
#pragma unroll
            for (int b = 0; b < 2; ++b)
#pragma unroll
                for (int m = 0; m < 4; ++m)
#pragma unroll
                    for (int n = 0; n < 2; ++n) acc[a][b][m][n] = (f32x4){0.f, 0.f, 0.f, 0.f};
        cur = nxt; cA = nA; cB = nB; ++ui;
        if constexpr (ALIGN_EPI) { if (wr == 1) PG8_BAR; }
    }
    PG8_WAIT_V(0);
    if constexpr (!ALIGN_EPI) { if (wr == 0) PG8_BAR; }
    PG8_BAR;
    if constexpr (Epi::AFTER_DRAIN) { E.fused(acc, cur, wr, wc, fr, fq, lds, wid, lane); S.done(cur); }
#undef PG8_SA
#undef PG8_SB
#undef PG8_STAGE
#undef PG8_LDA
#undef PG8_LDB
#undef PG8_MMA
#undef PG8_WAIT_V
#undef PG8_WAIT_L
#undef PG8_BAR
#undef PG8_SCHED
}
}
#include <hip/hip_bf16.h>
namespace attn_body {
using bf16=__hip_bfloat16;
using bf16x8=__attribute__((ext_vector_type(8)))short;
using s16x4=__attribute__((ext_vector_type(4)))short;
using f32x16=__attribute__((ext_vector_type(16)))float;
using u32x4=__attribute__((ext_vector_type(4)))unsigned;
constexpr int BATCH=2,NHEAD=8,SEQ=8192,D=64,QP=1024,KP=512;
constexpr int NW=8,QBLK=32,QB=QBLK*NW,KVBLK=64,NQB=SEQ/QB;
constexpr int ATTN_UNIT_ROWS=QB;
__device__ __forceinline__ int crow(int r,int hi){return (r&3)+8*(r>>2)+4*hi;}
#define SBAR() __builtin_amdgcn_sched_barrier(0)
__device__ __forceinline__ void cmask(f32x16&p0,f32x16&p1,int jb,int qrel,int hi){
  const float NEG=-INFINITY; int kb=64*jb+4*hi;
  #pragma unroll
  for(int r=0;r<16;++r){int kv=kb+(r&3)+8*(r>>2); if(kv>qrel)p0[r]=NEG; if(kv+32>qrel)p1[r]=NEG;}
}

constexpr int NSLOT=3, SLOTB=8192;
constexpr int LDS_K=0, LDS_V=NSLOT*SLOTB, LDS_WS=2*NSLOT*SLOTB, LDS_OST=LDS_WS+NW*64*4, LDS_CK=LDS_OST+NW*4096, LDS_BYTES=LDS_CK+SEQ*4;
constexpr float C2=0.125f*1.4426950408889634f;
__device__ __forceinline__ void glds16(const void*gsrc,unsigned lds_dst){unsigned keep;
  asm volatile("s_mov_b32 %0, m0\n\ts_mov_b32 m0, %2\n\ts_nop 0\n\tglobal_load_lds_dwordx4 %1, off\n\ts_mov_b32 m0, %0":"=&s"(keep):"v"(gsrc),"s"(lds_dst):"memory");}
__device__ __forceinline__ float max3f(float a,float b,float c){float r;asm("v_max3_f32 %0, %1, %2, %3":"=v"(r):"v"(a),"v"(b),"v"(c));return r;}
__device__ __forceinline__ float max2f(float a,float b){float r;asm("v_max_f32_e32 %0, %1, %2":"=v"(r):"v"(a),"v"(b));return r;}
__device__ __forceinline__ float fadd_s(float a,float b){float r;asm("v_add_f32_e32 %0, %1, %2":"=v"(r):"v"(a),"v"(b));return r;}
__device__ __forceinline__ float fsub_s(float a,float b){float r;asm("v_sub_f32_e32 %0, %1, %2":"=v"(r):"v"(a),"v"(b));return r;}
typedef float f32x2_t __attribute__((ext_vector_type(2))); typedef __bf16 bf16x2_t __attribute__((ext_vector_type(2)));
__device__ __forceinline__ unsigned cvtpk_s(float lo,float hi){f32x2_t v={lo,hi};bf16x2_t b=__builtin_convertvector(v,bf16x2_t);return __builtin_bit_cast(unsigned,b);}
#define WAIT_BAR(N) asm volatile("s_waitcnt vmcnt(" #N ") lgkmcnt(0)\n\ts_barrier":::"memory")

__device__ __forceinline__ void qkt(f32x16&p0,f32x16&p1,const char*Kslot,const bf16x8*qr,const f32x16&negm,int r32,int hi){
  const char*kb=Kslot+hi*1024+r32*16;
  #pragma unroll
  for(int d0=0;d0<4;++d0){
    const bf16x8 b0=*reinterpret_cast<const bf16x8*>(kb+d0*2048);
    const bf16x8 b1=*reinterpret_cast<const bf16x8*>(kb+d0*2048+512);
    if(d0==0){p0=__builtin_amdgcn_mfma_f32_32x32x16_bf16(b0,qr[0],negm,0,0,0);p1=__builtin_amdgcn_mfma_f32_32x32x16_bf16(b1,qr[0],negm,0,0,0);}
    else{p0=__builtin_amdgcn_mfma_f32_32x32x16_bf16(b0,qr[d0],p0,0,0,0);p1=__builtin_amdgcn_mfma_f32_32x32x16_bf16(b1,qr[d0],p1,0,0,0);}}
}
typedef __attribute__((address_space(3))) const char* lds_cptr;
typedef short v4i16_t __attribute__((ext_vector_type(4)));
__device__ __forceinline__ void kload8(bf16x8*kf,lds_cptr kp){
  kf[0]=*(const __attribute__((address_space(3))) bf16x8*)(kp);      kf[1]=*(const __attribute__((address_space(3))) bf16x8*)(kp+512);
  kf[2]=*(const __attribute__((address_space(3))) bf16x8*)(kp+2048); kf[3]=*(const __attribute__((address_space(3))) bf16x8*)(kp+2560);
  kf[4]=*(const __attribute__((address_space(3))) bf16x8*)(kp+4096); kf[5]=*(const __attribute__((address_space(3))) bf16x8*)(kp+4608);
  kf[6]=*(const __attribute__((address_space(3))) bf16x8*)(kp+6144); kf[7]=*(const __attribute__((address_space(3))) bf16x8*)(kp+6656);
}
__device__ __forceinline__ void kload2(bf16x8*kf,lds_cptr kp,int j){ kf[2*j]=*(const __attribute__((address_space(3))) bf16x8*)(kp+j*2048); kf[2*j+1]=*(const __attribute__((address_space(3))) bf16x8*)(kp+j*2048+512); }
__device__ __forceinline__ s16x4 vtr(lds_cptr p){ return __builtin_bit_cast(s16x4,__builtin_amdgcn_ds_read_tr16_b64_v4i16((__attribute__((address_space(3))) v4i16_t*)p)); }
__device__ __forceinline__ float rowmax(const f32x16&p0,const f32x16&p1){
  float a=max3f(p0[0],p0[1],p1[0]),b=max3f(p0[2],p0[3],p1[1]);a=max3f(a,p1[2],p1[3]);
  #pragma unroll
  for(int r=4;r<16;r+=4){a=max3f(a,p0[r],p0[r+1]);b=max3f(b,p0[r+2],p0[r+3]);a=max3f(a,p1[r],p1[r+1]);b=max3f(b,p1[r+2],p1[r+3]);}
  const float m=max2f(a,b);
  auto rr=__builtin_amdgcn_permlane32_swap(__float_as_uint(m),__float_as_uint(m),false,false);
  return max2f(__uint_as_float(rr[0]),__uint_as_float(rr[1]));
}
__device__ __forceinline__ void pv(f32x16*o,int vb,bf16x8 pa0,bf16x8 pa1,bf16x8 pa2,bf16x8 pa3){
  #pragma unroll
  for(int d0=0;d0<2;++d0){s16x4 lo[4],hi[4];
    #pragma unroll
    for(int ks=0;ks<4;++ks){
      asm volatile("ds_read_b64_tr_b16 %0,%1 offset:%c2":"=&v"(lo[ks]):"v"(vb),"i"(d0*4096+ks*1024):"memory");
      asm volatile("ds_read_b64_tr_b16 %0,%1 offset:%c2":"=&v"(hi[ks]):"v"(vb),"i"(d0*4096+ks*1024+512):"memory");}
    asm volatile("s_waitcnt lgkmcnt(0)":::"memory");SBAR();
    #define PK(k) (bf16x8){lo[k][0],lo[k][1],lo[k][2],lo[k][3],hi[k][0],hi[k][1],hi[k][2],hi[k][3]}
    o[d0]=__builtin_amdgcn_mfma_f32_32x32x16_bf16(pa0,PK(0),o[d0],0,0,0);
    o[d0]=__builtin_amdgcn_mfma_f32_32x32x16_bf16(pa1,PK(1),o[d0],0,0,0);
    o[d0]=__builtin_amdgcn_mfma_f32_32x32x16_bf16(pa2,PK(2),o[d0],0,0,0);
    o[d0]=__builtin_amdgcn_mfma_f32_32x32x16_bf16(pa3,PK(3),o[d0],0,0,0);
    #undef PK
  }
}

#ifndef ATTN_STORE16
#define ATTN_STORE16(p,v) (*(u32x4*)(p)=(v))
#endif
template<int THRL> __device__ __forceinline__ void attn_unit(int b,int h,int qb,const bf16*Q,const bf16*__restrict__ K,const bf16*__restrict__ V,bf16*O,const float*__restrict__ CK,const float*__restrict__ KMX,const float*__restrict__ QSV,char*shm){
  int tid_=threadIdx.x; asm volatile("":"+v"(tid_)); const int tid=tid_,lane=tid&63,r32=lane&31,hi=lane>>5; const int wid=__builtin_amdgcn_readfirstlane(tid>>6);
  const long rowbase=(long)b*SEQ; const int q0=qb*QB;
  int ts;
  { const int NT0=(q0+QB)/KVBLK; const float qmx=QSV[0],smn=QSV[1];
    bool ns0=true,ns1=true;
    if(lane<NT0){ const float bd=qmx*KMX[lane]-CK[64*lane+63]-smn; ns0=!(bd<-40.f); }
    if(lane+64<NT0){ const float bd=qmx*KMX[lane+64]-CK[64*(lane+64)+63]-smn; ns1=!(bd<-40.f); }
    const unsigned long long m0=__ballot(ns0),m1=__ballot(ns1);
    int first=m0?__builtin_ctzll(m0):(m1?64+__builtin_ctzll(m1):128);
    first=first<NT0-4?first:NT0-4; ts=__builtin_amdgcn_readfirstlane(first&~1); }
  CK+=ts*KVBLK;
  const bf16*Qw=Q+(rowbase+q0+wid*QBLK)*QP+h*D;
  const bf16*Kh=K+(rowbase+(long)ts*KVBLK)*KP+h*D,*Vh=V+(rowbase+(long)ts*KVBLK)*KP+h*D;
  const unsigned lds0=(unsigned)(uintptr_t)shm;
  typedef __attribute__((address_space(3))) const float* lds_fptr; typedef float f32x4v __attribute__((ext_vector_type(4))); const __attribute__((address_space(3))) char* shm3f=(const __attribute__((address_space(3))) char*)shm;
  float*wsf=(float*)(shm+LDS_WS)+wid*64;
  const bf16*ksrc=Kh+(long)lane*KP+wid*8;
  const bf16*vsrc=Vh+(long)(16*(wid&3)+(lane>>2))*KP+(wid>>2)*32+(lane&3)*8;
  const unsigned kdst=lds0+LDS_K+wid*1024, vdst=lds0+LDS_V+wid*1024;
  #define DMA_K(t,slot) glds16(ksrc+(long)(t)*KVBLK*KP,(unsigned)__builtin_amdgcn_readfirstlane(kdst+(slot)))
  #define DMA_V(t,slot) glds16(vsrc+(long)(t)*KVBLK*KP,(unsigned)__builtin_amdgcn_readfirstlane(vdst+(slot)))
  const int vb0=(int)(lds0+LDS_V)+((lane>>4)&1)*32+(lane&3)*8+(4*hi+((lane&15)>>2))*64;
  const char*Kbase=shm+LDS_K; bf16x8 kf[8];
  const lds_cptr shm3=(lds_cptr)shm; const lds_cptr kp0=shm3+LDS_K+hi*1024+r32*16; const lds_cptr vp0=shm3+LDS_V+((lane>>4)&1)*32+(lane&3)*8+(4*hi+((lane&15)>>2))*64;
  const int NT=(q0+QB)/KVBLK-ts;
  { float*ckw=(float*)(shm+LDS_CK); const int nk4=NT*(KVBLK/4);
    for(int i=tid;i<nk4;i+=NW*64){ const f32x4v c4=*reinterpret_cast<const f32x4v*>(CK+4*i); *reinterpret_cast<f32x4v*>(ckw+4*i)=c4; } }
  const lds_fptr ckl=(lds_fptr)(shm3f+LDS_CK)+4*hi;
  #define LDC(p) (*(const __attribute__((address_space(3))) f32x4v*)(p))
  #define KBIAS(P0,P1,t) do{ _Pragma("unroll") for(int g_=0;g_<4;++g_){ const f32x4v c0_=*(const __attribute__((address_space(3))) f32x4v*)(ckl+(t)*64+8*g_), c1_=*(const __attribute__((address_space(3))) f32x4v*)(ckl+(t)*64+32+8*g_); \
      _Pragma("unroll") for(int i_=0;i_<4;++i_){ P0[4*g_+i_]-=c0_[i_]; P1[4*g_+i_]-=c1_[i_]; } } }while(0)
  DMA_K(0,0);DMA_V(0,0);DMA_K(1,SLOTB);
  bf16x8 qr[4];
  #pragma unroll
  for(int d0=0;d0<4;++d0)qr[d0]=*reinterpret_cast<const bf16x8*>(&Qw[(long)r32*QP+d0*16+hi*8]);
  float mhat=0.f,l_reg=0.f;f32x16 o[2];o[0]=f32x16{};o[1]=f32x16{};const f32x16 zero16=f32x16{};
  const int qrel=wid*QBLK+r32;
  #define CMASK(P0,P1,t) do{int jb_=(t)-(NT-4); if(jb_>=0)cmask(P0,P1,jb_,qrel,hi);}while(0)
  bool resc=false;
  #define START(P0,P1) do{ const float rm=rowmax(P0,P1); resc=false; \
    { const float dl=rm; mhat=fadd_s(mhat,dl); \
      _Pragma("unroll") for(int r=0;r<16;++r){P0[r]=fsub_s(P0[r],dl);P1[r]=fsub_s(P1[r],dl);} \
      } \
    _Pragma("unroll") for(int r=0;r<16;++r)P0[r]=__builtin_amdgcn_exp2f(P0[r]); }while(0)
  #define RESC() do{ if(resc){ asm volatile("s_waitcnt lgkmcnt(0)":::"memory"); \
      _Pragma("unroll") for(int d_=0;d_<2;++d_) _Pragma("unroll") for(int r=0;r<16;++r)o[d_][r]*=wsf[crow(r,hi)]; } }while(0)
  f32x16 pA0,pA1,pB0,pB1;
  int sl_prev=0,sl_cur=0,sl_next=SLOTB;
  #define ROT() do{sl_prev=sl_cur;sl_cur=sl_next;sl_next=(sl_next==(NSLOT-1)*SLOTB)?0:sl_next+SLOTB;}while(0)
  DMA_K(2,2*SLOTB);
  WAIT_BAR(3);
  qkt(pA0,pA1,Kbase,qr,zero16,r32,hi);asm volatile("s_nop 15\n\ts_nop 7":"+v"(pA0),"+v"(pA1));KBIAS(pA0,pA1,0);CMASK(pA0,pA1,0);
  START(pA0,pA1);
  _Pragma("unroll") for(int r=0;r<16;++r)pA1[r]=__builtin_amdgcn_exp2f(pA1[r]);
  { const float nm_=-mhat; _Pragma("unroll") for(int g_=0;g_<4;++g_){ const f32x4v c0_=LDC(ckl+64+8*g_), c1_=LDC(ckl+64+32+8*g_);
      _Pragma("unroll") for(int i_=0;i_<4;++i_){ pB0[4*g_+i_]=nm_-c0_[i_]; pB1[4*g_+i_]=nm_-c1_[i_]; } } }
  WAIT_BAR(0);
  DMA_K(3,0);DMA_V(1,SLOTB);
  ROT();
  kload8(kf,kp0+sl_cur);
  WAIT_BAR(2);
  s16x4 vlo[8],vhi[8]; u32x4 pw0,pw1,pw2,pw3;
  #define PKW(P,B) cvtpk_s(P[B],P[B+1])
  #define PAF(k) __builtin_bit_cast(bf16x8,pw##k)
  #define VFR(i) (bf16x8){vlo[i][0],vlo[i][1],vlo[i][2],vlo[i][3],vhi[i][0],vhi[i][1],vhi[i][2],vhi[i][3]}
  #define PIN(x) asm volatile("":"+v"(x))
  #define MX3(a,b,c) __builtin_fmaxf(__builtin_fmaxf((a),(b)),(c))
  #define GAPA(MF,A0,A1,A2,A3,W0,W1,PW) do{ MF; sacc+=A0; sacc+=A1; sacc+=A2; sacc+=A3; PIN(sacc); W0; W1; PIN(PW); SBAR(); }while(0)
  #define EX(v) __builtin_amdgcn_exp2f(v)
  #define GAPB(MF,X,B,PN,CN,NXT) do{ MF; X[B]=EX(X[B]); X[B+1]=EX(X[B+1]); X[B+2]=EX(X[B+2]); X[B+3]=EX(X[B+3]); PIN(X); \
      PN[B]=nm_-cpre_[0]; PN[B+1]=nm_-cpre_[1]; PN[B+2]=nm_-cpre_[2]; PN[B+3]=nm_-cpre_[3]; PIN(PN); cpre_=LDC(ckn_+(NXT)); SBAR(); }while(0)
  #define VRD(i) do{ vlo[i]=vtr(vp_+(((i)>>2)*4096+((i)&3)*1024)); vhi[i]=vtr(vp_+(((i)>>2)*4096+((i)&3)*1024+512)); }while(0)
  #define KRD(G,j) do{ if(G){ kload2(kf,kp0+sl_next,j); SBAR(); } }while(0)
  #define STEP(C0,C1,P0,P1,t,GK,GV,GL) do{ SBAR(); \
    const lds_cptr vp_=vp0+sl_prev; \
    VRD(0); SBAR(); float sacc=(P0[0]+P0[1]); \
    GAPA(C0=__builtin_amdgcn_mfma_f32_32x32x16_bf16(kf[0],qr[0],C0,0,0,0), P0[2],P0[3],P0[4],P0[5],     pw0[0]=PKW(P0,0), pw0[1]=PKW(P0,2), pw0); \
    VRD(4); SBAR(); GAPA(C1=__builtin_amdgcn_mfma_f32_32x32x16_bf16(kf[1],qr[0],C1,0,0,0), P0[6],P0[7],P0[8],P0[9],     pw0[2]=PKW(P0,4), pw0[3]=PKW(P0,6), pw0); \
    VRD(1); SBAR(); GAPA(C0=__builtin_amdgcn_mfma_f32_32x32x16_bf16(kf[2],qr[1],C0,0,0,0),   P0[10],P0[11],P0[12],P0[13], pw1[0]=PKW(P0,8), pw1[1]=PKW(P0,10), pw1); \
    VRD(5); SBAR(); GAPA(C1=__builtin_amdgcn_mfma_f32_32x32x16_bf16(kf[3],qr[1],C1,0,0,0),   P0[14],P0[15],P1[0],P1[1],   pw1[2]=PKW(P0,12),pw1[3]=PKW(P0,14), pw1); \
    VRD(2); SBAR(); GAPA(C0=__builtin_amdgcn_mfma_f32_32x32x16_bf16(kf[4],qr[2],C0,0,0,0),   P1[2],P1[3],P1[4],P1[5],     pw2[0]=PKW(P1,0), pw2[1]=PKW(P1,2), pw2); \
    VRD(6); SBAR(); GAPA(C1=__builtin_amdgcn_mfma_f32_32x32x16_bf16(kf[5],qr[2],C1,0,0,0),   P1[6],P1[7],P1[8],P1[9],     pw2[2]=PKW(P1,4), pw2[3]=PKW(P1,6), pw2); \
    VRD(3); SBAR(); GAPA(C0=__builtin_amdgcn_mfma_f32_32x32x16_bf16(kf[6],qr[3],C0,0,0,0),   P1[10],P1[11],P1[12],P1[13], pw3[0]=PKW(P1,8), pw3[1]=PKW(P1,10), pw3); \
    VRD(7); SBAR(); GAPA(C1=__builtin_amdgcn_mfma_f32_32x32x16_bf16(kf[7],qr[3],C1,0,0,0),   P1[14],P1[15],0.f,0.f,       pw3[2]=PKW(P1,12),pw3[3]=PKW(P1,14), pw3); \
    l_reg+=sacc; \
    if(GK){DMA_K((t)+3,sl_cur);} if(GV){DMA_V((t)+1,sl_next);} \
    CMASK(C0,C1,t); \
    { float a=MX3(C0[0],C0[1],C1[0]),b=MX3(C0[2],C0[3],C1[1]); a=MX3(a,C1[2],C1[3]); \
      _Pragma("unroll") for(int r=4;r<16;r+=4){a=MX3(a,C0[r],C0[r+1]);b=MX3(b,C0[r+2],C0[r+3]);a=MX3(a,C1[r],C1[r+1]);b=MX3(b,C1[r+2],C1[r+3]);} \
      float rm=__builtin_fmaxf(a,b); { auto rr=__builtin_amdgcn_permlane32_swap(__float_as_uint(rm),__float_as_uint(rm),false,false); rm=__builtin_fmaxf(__uint_as_float(rr[0]),__uint_as_float(rr[1])); } \
      resc=false; \
      if(__builtin_expect(__any(rm>(float)THRL),0)){ const float dl=__builtin_fmaxf(rm,0.f); mhat+=dl; \
        _Pragma("unroll") for(int r=0;r<16;++r){C0[r]-=dl;C1[r]-=dl;} \
        const float f=__builtin_amdgcn_exp2f(-dl); l_reg*=f; if(hi==0)wsf[r32]=f; resc=true; } } \
    const float nm_=-mhat; const lds_fptr ckn_=ckl+((t)+1)*64; f32x4v cpre_=LDC(ckn_); \
    SBAR(); \
    GAPB(o[0]=__builtin_amdgcn_mfma_f32_32x32x16_bf16(PAF(0),VFR(0),o[0],0,0,0), C0,0, P0,0,8); \
    GAPB(o[1]=__builtin_amdgcn_mfma_f32_32x32x16_bf16(PAF(0),VFR(4),o[1],0,0,0), C0,4, P0,4,16); \
    KRD(GL,0); GAPB(o[0]=__builtin_amdgcn_mfma_f32_32x32x16_bf16(PAF(1),VFR(1),o[0],0,0,0), C0,8, P0,8,24); \
    KRD(GL,1); GAPB(o[1]=__builtin_amdgcn_mfma_f32_32x32x16_bf16(PAF(1),VFR(5),o[1],0,0,0), C0,12, P0,12,32); \
    KRD(GL,2); GAPB(o[0]=__builtin_amdgcn_mfma_f32_32x32x16_bf16(PAF(2),VFR(2),o[0],0,0,0), C1,0, P1,0,40); \
    KRD(GL,3); GAPB(o[1]=__builtin_amdgcn_mfma_f32_32x32x16_bf16(PAF(2),VFR(6),o[1],0,0,0), C1,4, P1,4,48); \
    GAPB(o[0]=__builtin_amdgcn_mfma_f32_32x32x16_bf16(PAF(3),VFR(3),o[0],0,0,0), C1,8, P1,8,56); \
    GAPB(o[1]=__builtin_amdgcn_mfma_f32_32x32x16_bf16(PAF(3),VFR(7),o[1],0,0,0), C1,12, P1,12,56); \
    }while(0)
  int t=1;
  #undef CMASK
  #define CMASK(P0,P1,t) do{}while(0)
  for(;t+5<NT;t+=2){
    STEP(pB0,pB1,pA0,pA1,t,true,true,true);     WAIT_BAR(2); RESC(); ROT();
    STEP(pA0,pA1,pB0,pB1,t+1,true,true,true);   WAIT_BAR(2); RESC(); ROT();
  }
  #undef CMASK
  #define CMASK(P0,P1,t) do{int jb_=(t)-(NT-4); if(jb_>=0)cmask(P0,P1,jb_,qrel,hi);}while(0)
  #define ENDW(tt) do{ if((tt)+3<NT){WAIT_BAR(2);} else if((tt)+2<NT){WAIT_BAR(1);} else {WAIT_BAR(0);} }while(0)
  for(;t+1<NT;t+=2){
    STEP(pB0,pB1,pA0,pA1,t,(t+3<NT),(t+1<NT),(t+1<NT));       ENDW(t);   RESC(); ROT();
    STEP(pA0,pA1,pB0,pB1,t+1,(t+4<NT),(t+2<NT),(t+2<NT));     ENDW(t+1); RESC(); ROT();
  }
  STEP(pB0,pB1,pA0,pA1,NT-1,false,false,false); RESC();
  { float sacc=pB0[0]+pB0[1]; _Pragma("unroll") for(int r=2;r<16;++r)sacc+=pB0[r]; _Pragma("unroll") for(int r=0;r<16;++r)sacc+=pB1[r]; l_reg+=sacc;
    pw0=(u32x4){PKW(pB0,0),PKW(pB0,2),PKW(pB0,4),PKW(pB0,6)};pw1=(u32x4){PKW(pB0,8),PKW(pB0,10),PKW(pB0,12),PKW(pB0,14)};pw2=(u32x4){PKW(pB1,0),PKW(pB1,2),PKW(pB1,4),PKW(pB1,6)};pw3=(u32x4){PKW(pB1,8),PKW(pB1,10),PKW(pB1,12),PKW(pB1,14)};
    SBAR(); pv(o,vb0+sl_cur,PAF(0),PAF(1),PAF(2),PAF(3)); }
  #undef PKW
  #undef PAF
  #undef VFR
  #undef PIN
  #undef MX3
  #undef GAPA
  #undef GAPB
  #undef EX
  #undef VRD
  #undef KRD
  #undef STEP
  #undef ENDW
  {auto rr=__builtin_amdgcn_permlane32_swap(__float_as_uint(l_reg),__float_as_uint(l_reg),false,false);l_reg=__uint_as_float(rr[0])+__uint_as_float(rr[1]);}
  if(hi==0)wsf[32+r32]=l_reg;asm volatile("s_waitcnt lgkmcnt(0)":::"memory");
  float rli[16];
  #pragma unroll
  for(int r=0;r<16;++r)rli[r]=__builtin_amdgcn_rcpf(wsf[32+crow(r,hi)]);
  bf16*Ow=O+(rowbase+q0+wid*QBLK)*QP+h*D;
  { bf16*stg=(bf16*)(shm+LDS_OST)+wid*2048;
    #pragma unroll
    for(int r=0;r<16;++r){const int orow=crow(r,hi);
      #pragma unroll
      for(int d0=0;d0<2;++d0)stg[orow*64+d0*32+r32]=__float2bfloat16(o[d0][r]*rli[r]);}
    asm volatile("s_waitcnt lgkmcnt(0)":::"memory");
    #pragma unroll
    for(int i=0;i<4;++i){const int row=i*8+(lane>>3),ch=lane&7; const u32x4 v=*(const u32x4*)(stg+row*64+ch*8); ATTN_STORE16(Ow+(long)row*QP+ch*8,v);} }
  asm volatile("s_waitcnt lgkmcnt(0)\n\ts_barrier":::"memory");
  #undef KBIAS
  #undef LDC
  #undef DMA_K
  #undef DMA_V
  #undef CMASK
  #undef START
  #undef RESC
  #undef ROT
}
constexpr int ATTN_LDS_BYTES=LDS_BYTES;
struct AttnTensors { const bf16* Q; const bf16* K; const bf16* V; bf16* O; const float* CK; const float* KMAX; const float* QS; };
struct AttnUnit { int bh; int qb; };
struct StaticOrder {
  int vcu,G; const int* ORD;
  __device__ __forceinline__ explicit StaticOrder(int grid,int block,const int*ord):vcu((grid%8==0)?(block%8)*(grid/8)+block/8:block),G(grid),ORD(ord){}
  __device__ __forceinline__ bool next(int i,AttnUnit&u)const{ const int v=vcu+(i>>1)*G; if(v>=256)return false; const int s=v&15; u.bh=(G==256)?__builtin_amdgcn_readfirstlane(ORD[2*v+(i&1)]):(v>>4); u.qb=(i&1)?s:31-s; return true; }
  __device__ __forceinline__ void a_ready(const AttnUnit&)const{}
  __device__ __forceinline__ void done(const AttnUnit&)const{}
};
template<class Sched,int THRL=8> __device__ __forceinline__ void attn_phase(char*lds,const AttnTensors&T,const Sched&S){
  AttnUnit u;
  for(int i=0;S.next(i,u);++i){ S.a_ready(u); attn_unit<THRL>(u.bh/NHEAD,u.bh%NHEAD,u.qb,T.Q,T.K,T.V,T.O,T.CK+(long)u.bh*SEQ,T.KMAX+u.bh*(SEQ/KVBLK),T.QS+(u.bh*NQB+u.qb)*2,lds); S.done(u); }
}
#undef SBAR
#undef WAIT_BAR
}
constexpr int BATCH = 2, SEQ = 8192, DM = 1024, DEPTH = 2, NMEM = 256, M = BATCH * SEQ, FFH = 2816, NIN = 3592, NINP = 3840, MROWS = BATCH * NMEM;
constexpr float EPS = 1e-6f, LOG2E = 1.4426950408889634f, C2Q = 0.125f * 1.4426950408889634f;
constexpr int NWAVES = 8, NTHREADS = 512;
constexpr size_t MiB = 1u << 20;
constexpr size_t WS_W1A = 0, WS_W1B = 11 * MiB, WS_WIN = 33 * MiB / 2, WS_WOUT = 24 * MiB, WS_WQ = 26 * MiB, WS_WKV = 28 * MiB, WS_WO = 32 * MiB, WS_W2A = 34 * MiB, WS_W2B = 45 * MiB;
constexpr size_t WS_MEMN = 51 * MiB, WS_KV = 52 * MiB, WS_SSQ = 54 * MiB, WS_LB = 55 * MiB, WS_C2 = 55 * MiB + 65536, WS_FF = 56 * MiB, WS_XB = 58 * MiB;
constexpr size_t WS_ACT = 90 * MiB, WS_QO = 90 * MiB, WS_VH = 122 * MiB, WS_GH = 138 * MiB, WS_LF = 154 * MiB, WS_FK = 186 * MiB, WS_FV = 202 * MiB, WS_END = 218 * MiB;
constexpr size_t WS_PB = 90 * MiB, WS_WQK = 218 * MiB, WS_VWO = 222 * MiB, WS_END2 = 226 * MiB;
constexpr int LDS_BYTES = 147456;

#define GAS __attribute__((address_space(1)))
#define LAS __attribute__((address_space(3)))
typedef unsigned short bf16;
typedef unsigned v4u __attribute__((ext_vector_type(4)));
typedef unsigned v2u __attribute__((ext_vector_type(2)));
typedef float f32x4 __attribute__((ext_vector_type(4)));
using pg8::cvt_pk_bf16;
__device__ __forceinline__ float bf2f(unsigned short h) { return __uint_as_float(((unsigned)h) << 16); }
__device__ __forceinline__ float bflo(unsigned w) { return __uint_as_float(w << 16); }
__device__ __forceinline__ float bfhi(unsigned w) { return __uint_as_float(w & 0xffff0000u); }
__device__ __forceinline__ unsigned short f2bf(float f) { return (unsigned short)(cvt_pk_bf16(f, 0.f) & 0xffffu); }
__device__ __forceinline__ float wave_sum(float v) {
#pragma unroll
    for (int o = 1; o < 64; o <<= 1) v += __shfl_xor(v, o);
    return v;
}
__device__ __forceinline__ float wave_max(float v) {
#pragma unroll
    for (int o = 1; o < 64; o <<= 1) v = fmaxf(v, __shfl_xor(v, o));
    return v;
}
__device__ __forceinline__ float silu_f(float x) { return x * __builtin_amdgcn_rcpf(1.f + __expf(-x)); }
__device__ __forceinline__ float logsig_f(float x) { return fminf(x, 0.f) - __logf(1.f + __expf(-fabsf(x))); }

__device__ __forceinline__ float row_rstd(const float* ssq, int row, int fq) {
    const f32x4 v = *(const f32x4*)(ssq + (size_t)row * 16 + fq * 4);
    float s = (v[0] + v[1]) + (v[2] + v[3]);
    s += __shfl_xor(s, 16); s += __shfl_xor(s, 32);
    return __builtin_amdgcn_rsqf(s * (1.f / DM) + EPS);
}
__device__ __forceinline__ void row_rstd4(const float* ssq, int row0, int fq, float (&rs)[4]) {
    f32x4 v[4];
#pragma unroll
    for (int m = 0; m < 4; ++m) v[m] = *(const f32x4*)(ssq + (size_t)(row0 + m * 16) * 16 + fq * 4);
#pragma unroll
    for (int m = 0; m < 4; ++m) { float t = (v[m][0] + v[m][1]) + (v[m][2] + v[m][3]); t += __shfl_xor(t, 16); t += __shfl_xor(t, 32); rs[m] = __builtin_amdgcn_rsqf(t * (1.f / DM) + EPS); }
}
__device__ __forceinline__ v4u pack8(const f32x4 a, const f32x4 b) { v4u w; w.x = cvt_pk_bf16(a[0], a[1]); w.y = cvt_pk_bf16(a[2], a[3]); w.z = cvt_pk_bf16(b[0], b[1]); w.w = cvt_pk_bf16(b[2], b[3]); return w; }

struct EpiSwiglu {
    static constexpr bool PERM = true, AFTER_DRAIN = false;
    bf16* O; const float* ssq;
    __device__ __forceinline__ void operator()(const f32x4 (&acc)[2][2][4][2], const pg8::Unit& u, int wr, int wc, int fr, int fq) const {
        const int row0 = u.pm * 256 + wr * 64 + fr, col0 = u.pn * 128 + wc * 32 + 8 * fq;
#pragma unroll
        for (int ai = 0; ai < 2; ++ai) { float rsv[4]; row_rstd4(ssq, row0 + ai * 128, fq, rsv);
#pragma unroll
            for (int m = 0; m < 4; ++m) {
                const int row = row0 + ai * 128 + m * 16; const float rs = rsv[m], c = -rs * LOG2E, rs2 = rs * rs;
                f32x4 e0 = acc[ai][0][m][0] * c, e1 = acc[ai][0][m][1] * c;
#pragma unroll
                for (int i = 0; i < 4; ++i) { e0[i] = __builtin_amdgcn_exp2f(e0[i]); e1[i] = __builtin_amdgcn_exp2f(e1[i]); }
                e0 = e0 + 1.0f; e1 = e1 + 1.0f;
#pragma unroll
                for (int i = 0; i < 4; ++i) { e0[i] = __builtin_amdgcn_rcpf(e0[i]); e1[i] = __builtin_amdgcn_rcpf(e1[i]); }
                const f32x4 h0 = (acc[ai][0][m][0] * acc[ai][1][m][0]) * rs2 * e0, h1 = (acc[ai][0][m][1] * acc[ai][1][m][1]) * rs2 * e1;
                *(v4u*)(O + (size_t)row * FFH + col0) = pack8(h0, h1);
            } }
    }
};
struct EpiRes {
    static constexpr bool PERM = true, AFTER_DRAIN = false;
    bf16* xb; float* ssq; float alpha;
    __device__ __forceinline__ void operator()(const f32x4 (&acc)[2][2][4][2], const pg8::Unit& u, int wr, int wc, int fr, int fq) const {
        const int row0 = u.pm * 256 + wr * 64 + fr, col0 = u.pn * 256 + wc * 32 + 8 * fq;
#pragma unroll
        for (int ai = 0; ai < 2; ++ai)
#pragma unroll
            for (int m = 0; m < 4; ++m) {
                const int row = row0 + ai * 128 + m * 16; float ss = 0.f;
#pragma unroll
                for (int bj = 0; bj < 2; ++bj) {
                    const size_t off = (size_t)row * DM + col0 + bj * 128;
                    const v4u b = *(const v4u*)(xb + off);
                    f32x4 v0, v1; v0[0] = bflo(b.x); v0[1] = bfhi(b.x); v0[2] = bflo(b.y); v0[3] = bfhi(b.y); v1[0] = bflo(b.z); v1[1] = bfhi(b.z); v1[2] = bflo(b.w); v1[3] = bfhi(b.w);
                    v0 = v0 + alpha * acc[ai][bj][m][0]; v1 = v1 + alpha * acc[ai][bj][m][1];
                    const v4u w = pack8(v0, v1); *(v4u*)(xb + off) = w;
                    const float r0 = bflo(w.x), r1 = bfhi(w.x), r2 = bflo(w.y), r3 = bfhi(w.y), r4 = bflo(w.z), r5 = bfhi(w.z), r6 = bflo(w.w), r7 = bfhi(w.w);
                    ss += (r0 * r0 + r1 * r1) + (r2 * r2 + r3 * r3) + (r4 * r4 + r5 * r5) + (r6 * r6 + r7 * r7);
                }
                ss += __shfl_xor(ss, 16); ss += __shfl_xor(ss, 32);
                if (fq == 0) ssq[(size_t)row * 16 + u.pn * 4 + wc] = ss;
            }
    }
};
struct EpiPlain {
    static constexpr bool PERM = true, AFTER_DRAIN = false;
    bf16* O; int ldc; const float* ssq; float scale;
    __device__ __forceinline__ void operator()(const f32x4 (&acc)[2][2][4][2], const pg8::Unit& u, int wr, int wc, int fr, int fq) const {
        const int row0 = u.pm * 256 + wr * 64 + fr, col0 = u.pn * 256 + wc * 32 + 8 * fq;
#pragma unroll
        for (int ai = 0; ai < 2; ++ai)
#pragma unroll
            for (int m = 0; m < 4; ++m) {
                const int row = row0 + ai * 128 + m * 16; const float rs = (ssq ? row_rstd(ssq, row, fq) : 1.f) * scale;
#pragma unroll
                for (int bj = 0; bj < 2; ++bj) *(v4u*)(O + (size_t)row * ldc + col0 + bj * 128) = pack8(acc[ai][bj][m][0] * rs, acc[ai][bj][m][1] * rs);
            }
    }
};
struct EpiWin {
    static constexpr bool PERM = true, AFTER_DRAIN = false;
    unsigned char* wsb; const float* lb; const float* fbias;
    __device__ __forceinline__ void operator()(const f32x4 (&acc)[2][2][4][2], const pg8::Unit& u, int wr, int wc, int fr, int fq) const {
        const int row0 = u.pm * 256 + wr * 64 + fr, pn = (u.pn == 3) ? 13 : (u.pn == 13) ? 3 : u.pn, cw = wc * 32 + 8 * fq;
        bf16* const QO = (bf16*)(wsb + WS_QO); bf16* const VH = (bf16*)(wsb + WS_VH); bf16* const GH = (bf16*)(wsb + WS_GH); bf16* const FK = (bf16*)(wsb + WS_FK); bf16* const FV = (bf16*)(wsb + WS_FV);
        float* const LF = (float*)(wsb + WS_LF); float* const FF = (float*)(wsb + WS_FF); const float* const ssq = (const float*)(wsb + WS_SSQ);
        if (pn == 14) {
            if (wc == 0 && fq == 0) {
                const f32x4 fb0 = *(const f32x4*)fbias, fb1 = *(const f32x4*)(fbias + 4);
#pragma unroll
                for (int ai = 0; ai < 2; ++ai)
#pragma unroll
                    for (int m = 0; m < 4; ++m) {
                        const int row = row0 + ai * 128 + m * 16;
                        const f32x4 sv = *(const f32x4*)(ssq + (size_t)row * 16), sv1 = *(const f32x4*)(ssq + (size_t)row * 16 + 4), sv2 = *(const f32x4*)(ssq + (size_t)row * 16 + 8), sv3 = *(const f32x4*)(ssq + (size_t)row * 16 + 12);
                        const float st = ((sv[0] + sv[1]) + (sv[2] + sv[3])) + ((sv1[0] + sv1[1]) + (sv1[2] + sv1[3])) + ((sv2[0] + sv2[1]) + (sv2[2] + sv2[3])) + ((sv3[0] + sv3[1]) + (sv3[2] + sv3[3]));
                        const float rs = __builtin_amdgcn_rsqf(st * (1.f / DM) + EPS);
                        f32x4 a = acc[ai][0][m][0] * rs, b = acc[ai][0][m][1] * rs;
#pragma unroll
                        for (int i = 0; i < 4; ++i) { a[i] = logsig_f(a[i] + fb0[i]) * LOG2E; b[i] = logsig_f(b[i] + fb1[i]) * LOG2E; }
                        *(f32x4*)(FF + (size_t)row * 8) = a; *(f32x4*)(FF + (size_t)row * 8 + 4) = b;
                        asm volatile("" ::: "memory");
                    }
            }
            return;
        }
        const int grp = pn >> 1, cb = (pn & 1) * 256 + cw;
#define WIN_LOOP(...) _Pragma("unroll") for (int ai = 0; ai < 2; ++ai) { _Pragma("unroll") for (int m = 0; m < 4; ++m) { const int row = row0 + ai * 128 + m * 16; const float rs = row_rstd(ssq, row, fq); \
            _Pragma("unroll") for (int bj = 0; bj < 2; ++bj) { f32x4 a = acc[ai][bj][m][0] * rs, b = acc[ai][bj][m][1] * rs; const int c = cb + bj * 128; __VA_ARGS__ } } asm volatile("" ::: "memory"); }
        if (grp == 0) { WIN_LOOP( _Pragma("unroll") for (int i = 0; i < 4; ++i) { a[i] = silu_f(a[i]); b[i] = silu_f(b[i]); } *(v4u*)(QO + (size_t)row * DM + c) = pack8(a, b); ) }
        else if (grp == 3) { WIN_LOOP( _Pragma("unroll") for (int i = 0; i < 4; ++i) { a[i] = silu_f(a[i]); b[i] = silu_f(b[i]); } *(v4u*)(GH + (size_t)row * 512 + c) = pack8(a, b); ) }
        else if (grp == 1) {
            f32x4 l0[2], l1[2];
#pragma unroll
            for (int bj = 0; bj < 2; ++bj) { l0[bj] = *(const f32x4*)(lb + cb + bj * 128); l1[bj] = *(const f32x4*)(lb + cb + bj * 128 + 4); }
            WIN_LOOP( _Pragma("unroll") for (int i = 0; i < 4; ++i) { const float s0 = fminf(a[i], 0.f) - __logf(1.f + __expf(-fabsf(a[i]))), s1 = fminf(b[i], 0.f) - __logf(1.f + __expf(-fabsf(b[i]))); const float la = l0[bj][i], lbv = l1[bj][i];
                    a[i] = la > 0.f ? __logf(la + (1.f - la) * __expf(s0)) : s0; b[i] = lbv > 0.f ? __logf(lbv + (1.f - lbv) * __expf(s1)) : s1; }
                *(f32x4*)(LF + (size_t)row * 512 + c) = a; *(f32x4*)(LF + (size_t)row * 512 + c + 4) = b; __builtin_amdgcn_sched_barrier(0); ) }
        else if (grp == 2) { WIN_LOOP( *(v4u*)(VH + (size_t)row * 512 + c) = pack8(a, b); ) }
        else if (grp == 4) { WIN_LOOP( *(v4u*)(QO + (size_t)row * DM + 512 + c) = pack8(a * C2Q, b * C2Q); ) }
        else if (grp == 5) { WIN_LOOP( *(v4u*)(FK + (size_t)row * 512 + c) = pack8(a, b); ) }
        else { WIN_LOOP( *(v4u*)(FV + (size_t)row * 512 + c) = pack8(a, b); ) }
#undef WIN_LOOP
    }
};

struct EpiFold {
    static constexpr bool PERM = true, AFTER_DRAIN = false;
    bf16* O; bool modeB; float scale;
    __device__ __forceinline__ void operator()(const f32x4 (&acc)[2][2][4][2], const pg8::Unit& u, int wr, int wc, int fr, int fq) const {
        const int hd = u.pm >> 3, b = (u.pm >> 2) & 1, q = u.pm & 3;
        const int rowb = modeB ? q * 256 : b * 1024 + hd * 256, colb = modeB ? hd * 256 : q * 256; bf16* Ob = O + (modeB ? (size_t)b * 1024 * 1024 : 0);
#pragma unroll
        for (int ai = 0; ai < 2; ++ai)
#pragma unroll
            for (int m = 0; m < 4; ++m) { const int row = rowb + ai * 128 + wr * 64 + m * 16 + fr;
#pragma unroll
                for (int bj = 0; bj < 2; ++bj) *(v4u*)(Ob + (size_t)row * 1024 + colb + bj * 128 + wc * 32 + 8 * fq) = pack8(acc[ai][bj][m][0] * scale, acc[ai][bj][m][1] * scale); }
    }
};
struct EpiSoftmax {
    static constexpr bool PERM = true, AFTER_DRAIN = false;
    bf16* P; const float* ssq; LAS float* xch;
    __device__ __forceinline__ void operator()(const f32x4 (&acc_)[2][2][4][2], const pg8::Unit& u, int wr, int wc, int fr, int fq) const {
        f32x4 (&acc)[2][2][4][2] = const_cast<f32x4 (&)[2][2][4][2]>(acc_);
        const int row0 = u.pm * 256 + wr * 64 + fr, lrow0 = wr * 64 + fr;
#pragma unroll
        for (int ai = 0; ai < 2; ++ai)
#pragma unroll
            for (int m = 0; m < 4; ++m) { const float rs = row_rstd(ssq, row0 + ai * 128 + m * 16, fq); float mx = -3.0e38f;
#pragma unroll
                for (int bj = 0; bj < 2; ++bj)
#pragma unroll
                    for (int n = 0; n < 2; ++n) { const f32x4 a = acc[ai][bj][m][n]; mx = fmaxf(mx, fmaxf(fmaxf(a[0], a[1]), fmaxf(a[2], a[3]))); }
                mx *= rs; mx = fmaxf(mx, __shfl_xor(mx, 16)); mx = fmaxf(mx, __shfl_xor(mx, 32));
                if (fq == 0) xch[(lrow0 + ai * 128 + m * 16) * 4 + wc] = mx; }
        asm volatile("s_waitcnt lgkmcnt(0)" ::: "memory"); __builtin_amdgcn_s_barrier(); asm volatile("" ::: "memory");
#pragma unroll
        for (int ai = 0; ai < 2; ++ai)
#pragma unroll
            for (int m = 0; m < 4; ++m) { const f32x4 x4 = *(const LAS f32x4*)(xch + (lrow0 + ai * 128 + m * 16) * 4); const float mrow = fmaxf(fmaxf(x4[0], x4[1]), fmaxf(x4[2], x4[3])), rs = row_rstd(ssq, row0 + ai * 128 + m * 16, fq); float sm = 0.f;
#pragma unroll
                for (int bj = 0; bj < 2; ++bj)
#pragma unroll
                    for (int n = 0; n < 2; ++n) { f32x4 a = acc[ai][bj][m][n];
#pragma unroll
                        for (int i = 0; i < 4; ++i) { a[i] = __expf(a[i] * rs - mrow); sm += a[i]; }
                        asm volatile("" ::: "memory");
                        acc[ai][bj][m][n] = a; }
                sm += __shfl_xor(sm, 16); sm += __shfl_xor(sm, 32);
                if (fq == 0) xch[1024 + (lrow0 + ai * 128 + m * 16) * 4 + wc] = sm; }
        asm volatile("s_waitcnt lgkmcnt(0)" ::: "memory"); __builtin_amdgcn_s_barrier(); asm volatile("" ::: "memory");
#pragma unroll
        for (int ai = 0; ai < 2; ++ai)
#pragma unroll
            for (int m = 0; m < 4; ++m) { const f32x4 x4 = *(const LAS f32x4*)(xch + 1024 + (lrow0 + ai * 128 + m * 16) * 4); const float inv = __builtin_amdgcn_rcpf((x4[0] + x4[1]) + (x4[2] + x4[3]));
#pragma unroll
                for (int bj = 0; bj < 2; ++bj) *(v4u*)(P + (size_t)(row0 + ai * 128 + m * 16) * DM + u.pn * 256 + bj * 128 + wc * 32 + 8 * fq) = pack8(acc[ai][bj][m][0] * inv, acc[ai][bj][m][1] * inv); }
        asm volatile("s_waitcnt lgkmcnt(0)" ::: "memory"); __builtin_amdgcn_s_barrier(); asm volatile("" ::: "memory");
    }
};
struct Args { const float* in[23]; float* out; unsigned char* ws; };
struct Frame {
    LAS unsigned char* lds; int tid, lane, wave, vcu, G;
    float* out; unsigned char* ws;
};
#define LDS_WAIT() asm volatile("s_waitcnt lgkmcnt(0)" ::: "memory")

__device__ __forceinline__ void transpose_item(const float* W, int K, int N, bf16* WT, int rs, int off, const float* sc, LAS float* scr, int item, int nblk, int lane, int swp) {
    const int kb = item / nblk, nb = item % nblk, k0 = 64 * kb, n0 = 32 * nb;
    const int n = n0 + (lane & 31);
    float tv[32];
#pragma unroll
    for (int i = 0; i < 32; ++i) tv[i] = 0.f;
    if (n < N) { const float* p = W + (size_t)(k0 + (lane >> 5)) * N + n; int stepv = 2 * N; asm volatile("" : "+v"(stepv));
#pragma unroll
        for (int i = 0; i < 32; ++i) { tv[i] = *p; p += stepv; } }
#pragma unroll
    for (int i = 0; i < 32; ++i) scr[(2 * i + (lane >> 5)) * 33 + (lane & 31)] = tv[i];
    LDS_WAIT(); asm volatile("" ::: "memory");
    const int c = lane & 7;
    f32x4 s0 = {1.f, 1.f, 1.f, 1.f}, s1 = s0; if (sc) { s0 = *(const f32x4*)(sc + k0 + 8 * c); s1 = *(const f32x4*)(sc + k0 + 8 * c + 4); }
#pragma unroll
    for (int j = 0; j < 4; ++j) { const int nn = (lane >> 3) + 8 * j; const LAS float* s = scr + (8 * c) * 33 + nn;
        v4u o; o.x = cvt_pk_bf16(s[0 * 33] * s0[0], s[1 * 33] * s0[1]); o.y = cvt_pk_bf16(s[2 * 33] * s0[2], s[3 * 33] * s0[3]); o.z = cvt_pk_bf16(s[4 * 33] * s1[0], s[5 * 33] * s1[1]); o.w = cvt_pk_bf16(s[6 * 33] * s1[2], s[7 * 33] * s1[3]);
        const int ng = n0 + nn, t256 = ng >> 8, ts256 = (t256 == 3) ? 13 : (t256 == 13) ? 3 : t256, dr = swp ? ts256 * 256 + (ng & 255) : (ng / 128) * rs + off + (ng % 128);
        *(v4u*)(WT + (size_t)dr * K + k0 + 8 * c) = o; }
    LDS_WAIT(); asm volatile("" ::: "memory");
}
__device__ __forceinline__ void row_to_bf16(const float* xrow, bf16* orow, float* ssqrow, bool normalise, int lane) {
    const f32x4* xr = (const f32x4*)xrow + lane; f32x4 v[4]; float s = 0.f;
#pragma unroll
    for (int j = 0; j < 4; ++j) { v[j] = xr[64 * j]; s += (v[j][0] * v[j][0] + v[j][1] * v[j][1]) + (v[j][2] * v[j][2] + v[j][3] * v[j][3]); }
    s = wave_sum(s);
    const float rs = normalise ? 1.0f / sqrtf(s * (1.f / DM) + EPS) : 1.f;
    v2u* o8 = (v2u*)orow + lane;
#pragma unroll
    for (int j = 0; j < 4; ++j) { v2u w; w.x = cvt_pk_bf16(v[j][0] * rs, v[j][1] * rs); w.y = cvt_pk_bf16(v[j][2] * rs, v[j][3] * rs); o8[64 * j] = w; }
    if (ssqrow && lane < 16) ssqrow[lane] = (lane == 0) ? s : 0.f;
}
__device__ __forceinline__ void prologue(Frame& F, const Args& A, int l) {
    LAS float* scr = (LAS float*)(F.lds + F.wave * 16384);
    const int gw = F.vcu * NWAVES + F.wave, NGW = F.G * NWAVES;
    unsigned char* ws = F.ws;
    const size_t oFF = (size_t)l * DM * FFH, oDD = (size_t)l * DM * DM;
    constexpr int I_GU = 16 * 88, I_DN = 44 * 32, I_IN = 16 * 120, I_SQ = 16 * 32;
    constexpr int NITEMS = 6 * 1408 + I_IN + 4 * I_SQ;
    for (int it = gw; it < NITEMS; it += NGW) {
        int r = it, si, sci = -1, K = DM, N = FFH, rs = 128, off = 0, nblk = 32; size_t so = oFF, dsto;
        if (r < 6 * 1408) { const int w = r / 1408; r -= w * 1408; const int second = w >= 3, t = w % 3;
            if (t < 2) { si = (second ? 19 : 3) + t; sci = second ? 18 : 2; rs = 256; off = 128 * t; nblk = 88; dsto = second ? WS_W2A : WS_W1A; }
            else { si = second ? 21 : 5; K = FFH; N = DM; dsto = second ? WS_W2B : WS_W1B; } }
        else { r -= 6 * 1408;
            if (r < I_IN) { si = 7; sci = 6; N = NIN; nblk = 120; so = (size_t)l * DM * NIN; dsto = WS_WIN; }
            else { r -= I_IN; const int w = r / I_SQ; r -= w * I_SQ; N = DM; so = oDD;
                si = (w == 0) ? 11 : 14 + w; sci = (w == 1 || w == 2) ? 13 : -1;
                dsto = (w == 0) ? WS_WOUT : (w == 1) ? WS_WKV : (w == 2) ? WS_WKV + (size_t)DM * DM * 2 : WS_WO; } }
        transpose_item(A.in[si] + so, K, N, (bf16*)(ws + dsto), rs, off, sci >= 0 ? A.in[sci] + l * DM : nullptr, scr, r, nblk, F.lane, si == 7 ? 1 : 0);
    }
    for (int d = gw; d < DM; d += NGW) {
        const float sc = A.in[12][l * DM + d]; const f32x4* src = (const f32x4*)(A.in[14] + oDD + (size_t)d * DM) + F.lane; v2u* dst = (v2u*)((bf16*)(ws + WS_WQ) + (size_t)d * DM) + F.lane;
#pragma unroll
        for (int j = 0; j < 4; ++j) { const f32x4 v = src[64 * j] * sc; v2u w; w.x = cvt_pk_bf16(v[0], v[1]); w.y = cvt_pk_bf16(v[2], v[3]); dst[64 * j] = w; }
    }
    if (l == 0) {
        for (int m = gw; m < M; m += NGW) row_to_bf16(A.in[0] + (size_t)m * DM, (bf16*)(ws + WS_XB) + (size_t)m * DM, (float*)(ws + WS_SSQ) + (size_t)m * 16, false, F.lane);
        for (int m = gw; m < MROWS; m += NGW) row_to_bf16(A.in[1] + (size_t)m * DM, (bf16*)(ws + WS_MEMN) + (size_t)m * DM, nullptr, true, F.lane);
        for (int k = F.vcu * NTHREADS + F.tid; k < 512; k += F.G * NTHREADS) {
            float mx = -1e30f; for (int j = 0; j < DEPTH; ++j) mx = fmaxf(mx, A.in[8][j * 512 + k]);
            float den = 0.f; for (int j = 0; j < DEPTH; ++j) den += __expf(A.in[8][j * 512 + k] - mx);
            float cum = 0.f; for (int j = 0; j < DEPTH; ++j) { if (j > 0) cum += __expf(A.in[8][j * 512 + k] - mx) / den; ((float*)(ws + WS_LB))[j * 512 + k] = cum; }
        }
    }
}

__device__ __forceinline__ void fox_cumsum_unit(Frame& F, int bh) {
    const int b = bh >> 3, h = bh & 7; const float* FFp = (const float*)(F.ws + WS_FF); float* C2 = (float*)(F.ws + WS_C2);
    LAS float* wt = (LAS float*)F.lds;
    float v[16]; float run = 0.f;
#pragma unroll
    for (int i = 0; i < 16; ++i) v[i] = FFp[(size_t)(b * SEQ + F.tid * 16 + i) * 8 + h];
#pragma unroll
    for (int i = 0; i < 16; ++i) { run += v[i]; v[i] = run; }
    float inc = run;
#pragma unroll
    for (int o = 1; o < 64; o <<= 1) { const float t = __shfl_up(inc, o); if (F.lane >= o) inc += t; }
    if (F.lane == 63) wt[F.wave] = inc;
    __syncthreads();
    float base = inc - run;
    for (int w = 0; w < F.wave; ++w) base += wt[w];
#pragma unroll
    for (int i4 = 0; i4 < 4; ++i4) { f32x4 o4;
#pragma unroll
        for (int i = 0; i < 4; ++i) o4[i] = base + v[i4 * 4 + i];
        *(f32x4*)(C2 + (size_t)bh * SEQ + F.tid * 16 + i4 * 4) = o4; }
    __syncthreads();
}
constexpr size_t WS_KMAX = WS_LB + 8192, WS_QS = WS_LB + 16384, WS_ORD = WS_LB + 24576;
constexpr size_t WS_KMAX_ = 0;
__device__ __forceinline__ float sq8(const v4u w) { const float a0 = bflo(w.x), a1 = bfhi(w.x), a2 = bflo(w.y), a3 = bfhi(w.y), a4 = bflo(w.z), a5 = bfhi(w.z), a6 = bflo(w.w), a7 = bfhi(w.w); return (a0 * a0 + a1 * a1) + (a2 * a2 + a3 * a3) + (a4 * a4 + a5 * a5) + (a6 * a6 + a7 * a7); }
__device__ __forceinline__ float dot8(const v4u a, const v4u b) { return (bflo(a.x) * bflo(b.x) + bfhi(a.x) * bfhi(b.x)) + (bflo(a.y) * bflo(b.y) + bfhi(a.y) * bfhi(b.y)) + (bflo(a.z) * bflo(b.z) + bfhi(a.z) * bfhi(b.z)) + (bflo(a.w) * bflo(b.w) + bfhi(a.w) * bfhi(b.w)); }
__device__ __forceinline__ void fox_bounds(Frame& F) {
    const bf16* QO = (const bf16*)(F.ws + WS_QO); const bf16* FK = (const bf16*)(F.ws + WS_FK); const float* C2 = (const float*)(F.ws + WS_C2);
    float* KMAX = (float*)(F.ws + WS_KMAX); float* QS = (float*)(F.ws + WS_QS);
    if (F.wave < 4) return;
    const int gw = F.vcu * 4 + (F.wave - 4), NGW = F.G * 4;
    for (int item = gw; item < 2048 + 512; item += NGW) {
        if (item < 2048) { const int bh = item >> 7, t = item & 127, b = bh >> 3, h = bh & 7; const v4u* kp = (const v4u*)(FK + ((size_t)b * SEQ + t * 64 + F.lane) * 512 + h * 64);
            float k2 = 0.f;
#pragma unroll
            for (int d8 = 0; d8 < 8; ++d8) k2 += sq8(kp[d8]);
            k2 = wave_max(k2); if (F.lane == 0) KMAX[item] = sqrtf(k2);
        } else { const int it = item - 2048, bh = it >> 5, qb = it & 31, b = bh >> 3, h = bh & 7; float q2 = 0.f, sm = 3.0e38f;
#pragma unroll
            for (int r = 0; r < 4; ++r) { const int i = qb * 256 + F.lane + 64 * r; const size_t row = (size_t)b * SEQ + i;
                const v4u* qp = (const v4u*)(QO + row * DM + 512 + h * 64); const v4u* kp = (const v4u*)(FK + row * 512 + h * 64); float qq = 0.f, qk = 0.f;
#pragma unroll
                for (int d8 = 0; d8 < 8; ++d8) { const v4u qv = qp[d8]; qq += sq8(qv); qk += dot8(qv, kp[d8]); }
                q2 = fmaxf(q2, qq); sm = fminf(sm, qk - C2[(size_t)bh * SEQ + i]); }
            q2 = wave_max(q2); sm = -wave_max(-sm);
            if (F.lane == 0) { QS[it * 2] = sqrtf(q2); QS[it * 2 + 1] = sm; }
        }
    }
    if (F.wave == 4 && F.vcu < 256) {
        const int l16 = F.lane & 15; const float v = C2[(size_t)l16 * SEQ + SEQ - 1]; int rank = 0;
#pragma unroll
        for (int m = 0; m < 16; ++m) { const float vm = __shfl(v, m); rank += (vm < v || (vm == v && m < l16)) ? 1 : 0; }
        const int g = (F.vcu >> 4) & 15;
        const unsigned long long ma = __ballot(rank == g && F.lane < 16), mb = __ballot(rank == 15 - g && F.lane < 16);
        if (F.lane == 0) { int* ORD = (int*)(F.ws + WS_ORD); ORD[2 * F.vcu] = ma ? (int)__builtin_ctzll(ma) : g; ORD[2 * F.vcu + 1] = mb ? (int)__builtin_ctzll(mb) : 15 - g; }
    }
}
typedef short bf16x8_t __attribute__((ext_vector_type(8)));
__device__ __forceinline__ f32x4 mma16(bf16x8_t x, bf16x8_t y, f32x4 c) { return __builtin_amdgcn_mfma_f32_16x16x32_bf16(x, y, c, 0, 0, 0); }
constexpr int HG_LDK = 136, HG_LDS = 72;
constexpr int P1_QM = 0, P1_KM = 17408, P1_KLT = 34816, P1_VT = 53248, P1_AM = 71680, P1_TOT = 80896;
constexpr size_t WS_HD = 57 * MiB;
__device__ __forceinline__ void hgrn_pass1_unit(Frame& F, int unit) {
    const int bh = unit >> 7, c = unit & 127, b = bh >> 2, h = bh & 3; const size_t row0 = (size_t)b * SEQ + c * 64;
    float* LF = (float*)(F.ws + WS_LF); bf16* QO = (bf16*)(F.ws + WS_QO); const bf16* VH = (const bf16*)(F.ws + WS_VH);
    bf16* UT = (bf16*)F.out + (size_t)unit * 16384; float* HD = (float*)(F.ws + WS_HD) + (size_t)unit * 128;
    LAS bf16* Qm = (LAS bf16*)(F.lds + P1_QM); LAS bf16* Km = (LAS bf16*)(F.lds + P1_KM); LAS bf16* KlT = (LAS bf16*)(F.lds + P1_KLT); LAS bf16* VT = (LAS bf16*)(F.lds + P1_VT); LAS bf16* Am = (LAS bf16*)(F.lds + P1_AM);
    LAS float* tot = (LAS float*)(F.lds + P1_TOT);
    const int k = F.tid & 127, tq = F.tid >> 7, fr = F.lane & 15, fq = F.lane >> 4;
    float lf[16], g[16]; unsigned short qv[16], vv[16];
#pragma unroll
    for (int i = 0; i < 16; ++i) { const size_t r = row0 + 16 * tq + i; lf[i] = LF[r * 512 + h * 128 + k]; qv[i] = QO[r * DM + h * 128 + k]; vv[i] = VH[r * 512 + h * 128 + k]; }
    float run = 0.f;
#pragma unroll
    for (int i = 0; i < 16; ++i) { run += lf[i]; g[i] = run; }
    tot[tq * 128 + k] = run;
    { v4u w0, w1; w0.x = vv[0] | (vv[1] << 16); w0.y = vv[2] | (vv[3] << 16); w0.z = vv[4] | (vv[5] << 16); w0.w = vv[6] | (vv[7] << 16); w1.x = vv[8] | (vv[9] << 16); w1.y = vv[10] | (vv[11] << 16); w1.z = vv[12] | (vv[13] << 16); w1.w = vv[14] | (vv[15] << 16);
      *(LAS v4u*)(VT + k * HG_LDS + 16 * tq) = w0; *(LAS v4u*)(VT + k * HG_LDS + 16 * tq + 8) = w1; }
    __syncthreads();
    const float t0 = tot[k], t1 = tot[128 + k], t2 = tot[256 + k], t3 = tot[384 + k];
    const float off = (tq > 0 ? t0 : 0.f) + (tq > 1 ? t1 : 0.f) + (tq > 2 ? t2 : 0.f), gmid = t0 + t1, glast = gmid + t2 + t3;
    float kl[16];
#pragma unroll
    for (int i = 0; i < 16; ++i) { const size_t r = row0 + 16 * tq + i; const float gi = off + g[i], q = bf2f(qv[i]), kk = 1.f - __expf(lf[i]);
        QO[r * DM + h * 128 + k] = f2bf(q * __expf(gi));
        Qm[(16 * tq + i) * HG_LDK + k] = f2bf(q * __expf(fminf(gi - gmid, 80.f)));
        Km[(16 * tq + i) * HG_LDK + k] = f2bf(kk * __expf(fminf(gmid - gi, 80.f)));
        kl[i] = kk * __expf(glast - gi); }
    { v4u w0, w1; w0.x = cvt_pk_bf16(kl[0], kl[1]); w0.y = cvt_pk_bf16(kl[2], kl[3]); w0.z = cvt_pk_bf16(kl[4], kl[5]); w0.w = cvt_pk_bf16(kl[6], kl[7]); w1.x = cvt_pk_bf16(kl[8], kl[9]); w1.y = cvt_pk_bf16(kl[10], kl[11]); w1.z = cvt_pk_bf16(kl[12], kl[13]); w1.w = cvt_pk_bf16(kl[14], kl[15]);
      *(LAS v4u*)(KlT + k * HG_LDS + 16 * tq) = w0; *(LAS v4u*)(KlT + k * HG_LDS + 16 * tq + 8) = w1; }
    if (tq == 0) HD[k] = __expf(glast);
    __syncthreads();
#pragma unroll
    for (int it = 0; it < 2; ++it) { const int idx = F.wave + 8 * it, st = idx >> 2, tt = idx & 3; f32x4 a = {0.f, 0.f, 0.f, 0.f};
        if (st <= tt) {
#pragma unroll
            for (int kk = 0; kk < 4; ++kk) a = mma16(*(const LAS bf16x8_t*)(Km + (16 * st + fr) * HG_LDK + 8 * fq + 32 * kk), *(const LAS bf16x8_t*)(Qm + (16 * tt + fr) * HG_LDK + 8 * fq + 32 * kk), a);
        }
        const int s0 = 16 * st + 4 * fq, t = 16 * tt + fr;
#pragma unroll
        for (int j = 0; j < 4; ++j) a[j] = (s0 + j <= t) ? a[j] : 0.f;
        v2u w; w.x = cvt_pk_bf16(a[0], a[1]); w.y = cvt_pk_bf16(a[2], a[3]); *(LAS v2u*)(Am + t * HG_LDS + s0) = w; }
    { const bf16x8_t x0 = *(const LAS bf16x8_t*)(KlT + (16 * F.wave + fr) * HG_LDS + 8 * fq), x1 = *(const LAS bf16x8_t*)(KlT + (16 * F.wave + fr) * HG_LDS + 8 * fq + 32);
#pragma unroll
      for (int vt = 0; vt < 8; ++vt) { f32x4 a = {0.f, 0.f, 0.f, 0.f};
          a = mma16(x0, *(const LAS bf16x8_t*)(VT + (16 * vt + fr) * HG_LDS + 8 * fq), a); a = mma16(x1, *(const LAS bf16x8_t*)(VT + (16 * vt + fr) * HG_LDS + 8 * fq + 32), a);
          v2u w; w.x = cvt_pk_bf16(a[0], a[1]); w.y = cvt_pk_bf16(a[2], a[3]); *(v2u*)(UT + (16 * vt + fr) * 128 + 16 * F.wave + 4 * fq) = w; } }
    __syncthreads();
    { const bf16x8_t x0 = *(const LAS bf16x8_t*)(VT + (16 * F.wave + fr) * HG_LDS + 8 * fq), x1 = *(const LAS bf16x8_t*)(VT + (16 * F.wave + fr) * HG_LDS + 8 * fq + 32);
#pragma unroll
      for (int tt = 0; tt < 4; ++tt) { f32x4 a = {0.f, 0.f, 0.f, 0.f};
          a = mma16(x0, *(const LAS bf16x8_t*)(Am + (16 * tt + fr) * HG_LDS + 8 * fq), a); a = mma16(x1, *(const LAS bf16x8_t*)(Am + (16 * tt + fr) * HG_LDS + 8 * fq + 32), a);
          v2u w; w.x = cvt_pk_bf16(a[0], a[1]); w.y = cvt_pk_bf16(a[2], a[3]); *(v2u*)((bf16*)F.out + (size_t)16 * 1024 * 1024 + (row0 + 16 * tt + fr) * 512 + h * 128 + 16 * F.wave + 4 * fq) = w; } }
    __syncthreads();
}
__device__ __forceinline__ void hgrn_pass2(Frame& F) {
    if (F.tid >= 256) return;
    for (int item = F.vcu * 256 + F.tid; item < 8 * 128 * 64; item += F.G * 256) {
        const int bh = item >> 13, rem = item & 8191;
        unsigned* up = (unsigned*)((bf16*)F.out + (size_t)bh * 128 * 16384) + rem; const float2* dp = (const float2*)((const float*)(F.ws + WS_HD) + (size_t)bh * 128 * 128) + (rem & 63);
        float s0 = 0.f, s1 = 0.f;
#pragma unroll 32
        for (int c = 0; c < 128; ++c) { const unsigned u = up[(size_t)c * 8192]; const float2 d = dp[c * 64];
            up[(size_t)c * 8192] = cvt_pk_bf16(s0, s1);
            s0 = d.x * s0 + bflo(u); s1 = d.y * s1 + bfhi(u); }
    }
}
__device__ __forceinline__ void hgrn_pass3_unit(Frame& F, const float* onw, int pu) {
    const int unit0 = 2 * pu, fr = F.lane & 15, fq = F.lane >> 4;
    const bf16* UT = (const bf16*)F.out + (size_t)unit0 * 16384; const float* LF = (const float*)(F.ws + WS_LF); bf16* QO = (bf16*)(F.ws + WS_QO); const bf16* GH = (const bf16*)(F.ws + WS_GH);
#pragma unroll
    for (int i = 0; i < 8; ++i) { const int p = F.tid + 512 * i, cc = p >> 11, q = p & 2047, v = q >> 4, c8 = q & 15;
        *(LAS v4u*)(F.lds + cc * 34816 + v * 272 + c8 * 16) = *(const v4u*)(UT + (size_t)cc * 16384 + v * 128 + c8 * 8); }
    __syncthreads();
    const int cc = F.wave >> 2, tt = F.wave & 3, unit = unit0 + cc, bh = unit >> 7, c = unit & 127, b = bh >> 2, h = bh & 3;
    const size_t row = (size_t)b * SEQ + c * 64 + 16 * tt + fr;
    bf16x8_t yq[4];
#pragma unroll
    for (int kk = 0; kk < 4; ++kk) yq[kk] = *(const bf16x8_t*)(QO + row * DM + h * 128 + 8 * fq + 32 * kk);
    f32x4 o[8]; float ss = 0.f;
#pragma unroll
    for (int vt = 0; vt < 8; ++vt) { const v2u oi = *(const v2u*)((const bf16*)F.out + (size_t)16 * 1024 * 1024 + row * 512 + h * 128 + 16 * vt + 4 * fq); f32x4 a; a[0] = bflo(oi.x); a[1] = bfhi(oi.x); a[2] = bflo(oi.y); a[3] = bfhi(oi.y);
#pragma unroll
        for (int kk = 0; kk < 4; ++kk) a = mma16(*(const LAS bf16x8_t*)(F.lds + cc * 34816 + (16 * vt + fr) * 272 + (8 * fq + 32 * kk) * 2), yq[kk], a);
        o[vt] = a; ss += (a[0] * a[0] + a[1] * a[1]) + (a[2] * a[2] + a[3] * a[3]); }
    ss += __shfl_xor(ss, 16); ss += __shfl_xor(ss, 32);
    const float rs = __builtin_amdgcn_rsqf(ss * (1.f / 128.f) + EPS);
#pragma unroll
    for (int vt = 0; vt < 8; ++vt) { const int v0 = 16 * vt + 4 * fq; const f32x4 w4 = *(const f32x4*)(onw + v0); const v2u gt = *(const v2u*)(GH + row * 512 + h * 128 + v0);
        v2u w; w.x = cvt_pk_bf16(o[vt][0] * rs * w4[0] * bflo(gt.x), o[vt][1] * rs * w4[1] * bfhi(gt.x)); w.y = cvt_pk_bf16(o[vt][2] * rs * w4[2] * bflo(gt.y), o[vt][3] * rs * w4[3] * bfhi(gt.y));
        *(v2u*)(QO + row * DM + h * 128 + v0) = w; }
    __syncthreads();
}
__device__ __forceinline__ void final_norm(Frame& F, const float* w) {
    const int gw = F.vcu * NWAVES + F.wave, NGW = F.G * NWAVES; const float* ssq = (const float*)(F.ws + WS_SSQ); const bf16* XBp = (const bf16*)(F.ws + WS_XB);
    f32x4 wv[4];
#pragma unroll
    for (int j = 0; j < 4; ++j) wv[j] = ((const f32x4*)w + F.lane)[64 * j];
    for (int m = gw; m < M; m += 2 * NGW) {
        const int m1 = m + NGW; const bool two = m1 < M; const int mb = two ? m1 : m;
        float s0 = (F.lane < 16) ? ssq[(size_t)m * 16 + F.lane] : 0.f, s1 = (F.lane < 16) ? ssq[(size_t)mb * 16 + F.lane] : 0.f;
        const v2u* x0 = (const v2u*)(XBp + (size_t)m * DM) + F.lane; const v2u* x1 = (const v2u*)(XBp + (size_t)mb * DM) + F.lane;
        v2u b0[4], b1[4];
#pragma unroll
        for (int j = 0; j < 4; ++j) { b0[j] = x0[64 * j]; b1[j] = x1[64 * j]; }
        s0 = wave_sum(s0); s1 = wave_sum(s1);
        const float r0 = __builtin_amdgcn_rsqf(s0 * (1.f / DM) + EPS), r1 = __builtin_amdgcn_rsqf(s1 * (1.f / DM) + EPS);
        f32x4* o0 = (f32x4*)(F.out + (size_t)m * DM) + F.lane; f32x4* o1 = (f32x4*)(F.out + (size_t)mb * DM) + F.lane;
#pragma unroll
        for (int j = 0; j < 4; ++j) { f32x4 v; v[0] = bflo(b0[j].x); v[1] = bfhi(b0[j].x); v[2] = bflo(b0[j].y); v[3] = bfhi(b0[j].y); o0[64 * j] = v * r0 * wv[j]; }
        if (two) {
#pragma unroll
            for (int j = 0; j < 4; ++j) { f32x4 v; v[0] = bflo(b1[j].x); v[1] = bfhi(b1[j].x); v[2] = bflo(b1[j].y); v[3] = bfhi(b1[j].y); o1[64 * j] = v * r1 * wv[j]; } }
    }
}
#define RLX_AGENT __ATOMIC_RELAXED, __HIP_MEMORY_SCOPE_AGENT
#define XB_TMO      128
#define XB_XCNT(j)  (256  + 64 * (j))
#define XB_XSUB(j)  (1280 + 64 * (j))
#define XB_XGEN(j)  (2304 + 64 * (j))
#define XB_TOP      3328
#define XB_TOPGEN   3392
#define XB_SPIN_CAP (1u << 22)
__device__ __forceinline__ unsigned xb_ld_u(unsigned* p) { return (unsigned)__builtin_amdgcn_readfirstlane((int)__hip_atomic_load(p, RLX_AGENT)); }
__device__ __forceinline__ unsigned xb_add_u(unsigned* p, unsigned v, int lane) { unsigned r = 0u; if (lane == 0) r = __hip_atomic_fetch_add(p, v, RLX_AGENT); return (unsigned)__builtin_amdgcn_readfirstlane((int)r); }
__device__ __forceinline__ unsigned xb_xcc_id() { return (unsigned)__builtin_amdgcn_s_getreg((3 << 11) | 20) & 0xFu; }
#define XB_SPIN_U(cond, bar) do { unsigned _sp = 0; while (cond) { __builtin_amdgcn_s_sleep(1); if (++_sp > XB_SPIN_CAP) { if (lane == 0) atomicAdd(&(bar)[XB_TMO], 1u); break; } } } while (0)
__device__ __forceinline__ void xcd_barrier(unsigned* bar, volatile __attribute__((address_space(3))) unsigned* st, int wave, int lane) {
    asm volatile("s_waitcnt vmcnt(0)" ::: "memory");
    __syncthreads();
    if (wave == 0) {
        __builtin_amdgcn_s_waitcnt(0);
        const unsigned x = xb_xcc_id();
        unsigned nloc = (unsigned)__builtin_amdgcn_readfirstlane((int)st[0]), nx = (unsigned)__builtin_amdgcn_readfirstlane((int)st[1]);
        if (nloc == 0u) {
            const unsigned G = gridDim.x; unsigned sp = 0u;
            (void)xb_add_u(&bar[XB_XCNT(x)], 1u, lane);
            for (;;) { unsigned sum = 0u, cnt = 0u, mine = 0u;
#pragma unroll
                for (unsigned j = 0; j < 16; ++j) { const unsigned c = xb_ld_u(&bar[XB_XCNT(j)]); sum += c; cnt += (c > 0u) ? 1u : 0u; mine = (j == x) ? c : mine; }
                nloc = mine > 0u ? mine : 1u; nx = cnt > 0u ? cnt : 1u;
                if (sum == G) break;
                __builtin_amdgcn_s_sleep(1);
                if (++sp > XB_SPIN_CAP) { if (lane == 0) atomicAdd(&bar[XB_TMO], 1u); break; } }
            if (lane == 0) { st[0] = nloc; st[1] = nx; }
        }
        const unsigned old = xb_add_u(&bar[XB_XSUB(x)], 1u, lane), gen = old / nloc;
        if (old + 1u == (gen + 1u) * nloc) {
            __builtin_amdgcn_fence(__ATOMIC_RELEASE, "agent");
            asm volatile("s_waitcnt vmcnt(0)" ::: "memory");
            const unsigned og = xb_add_u(&bar[XB_TOP], 1u, lane), tg = og / nx;
            if (og + 1u == (tg + 1u) * nx) (void)xb_add_u(&bar[XB_TOPGEN], 1u, lane);
            else XB_SPIN_U(xb_ld_u(&bar[XB_TOPGEN]) == tg, bar);
            __builtin_amdgcn_fence(__ATOMIC_ACQUIRE, "agent");
            (void)xb_add_u(&bar[XB_XGEN(x)], 1u, lane);
            asm volatile("s_waitcnt vmcnt(0)" ::: "memory");
        } else {
            XB_SPIN_U(xb_ld_u(&bar[XB_XGEN(x)]) == gen, bar);
            __builtin_amdgcn_fence(__ATOMIC_ACQUIRE, "agent");
            asm volatile("s_waitcnt vmcnt(0)" ::: "memory");
        }
    }
    __syncthreads();
}

constexpr size_t WS_CTL = 226 * MiB, CTL_BYTES = 65536, WS_END3 = 227 * MiB;
constexpr int LDS_MISC = 139264;
template <class T> __device__ __forceinline__ T* uni_ptr(T* p) { const unsigned long long v = (unsigned long long)p; const unsigned lo = __builtin_amdgcn_readfirstlane((unsigned)v), hi = __builtin_amdgcn_readfirstlane((unsigned)(v >> 32)); return (T*)(((unsigned long long)hi << 32) | lo); }
__global__ void __launch_bounds__(NTHREADS, 2) mega_fwd(Args args) {
    extern __shared__ __attribute__((aligned(16))) unsigned char lds[];
    cg::grid_group grid = cg::this_grid();
    #define PHASE_PTRS int bx_ = blockIdx.x; asm volatile("" : "+s"(bx_)); int G_ = gridDim.x; asm volatile("" : "+s"(G_)); (void)bx_; (void)G_; LAS unsigned char* ldsp = (LAS unsigned char*)lds; asm volatile("" : "+s"(ldsp)); (void)ldsp; unsigned char* ws = args.ws; asm volatile("" : "+s"(ws)); float* outp = args.out; asm volatile("" : "+s"(outp)); bf16* XB = (bf16*)(ws + WS_XB); float* SSQ = (float*)(ws + WS_SSQ); bf16* ACT = (bf16*)(ws + WS_ACT); (void)XB; (void)SSQ; (void)ACT; (void)outp;
#define MKFRAME Frame F; { int t_ = threadIdx.x; asm volatile("" : "+v"(t_)); F.lds = ldsp; F.tid = t_; F.lane = t_ & 63; F.wave = __builtin_amdgcn_readfirstlane(t_ >> 6); F.G = G_; F.vcu = (G_ % 8 == 0) ? (bx_ % 8) * (G_ / 8) + bx_ / 8 : bx_; F.ws = ws; F.out = outp; }
#define GSYNC() do { LAS unsigned char* l_ = (LAS unsigned char*)lds; asm volatile("" : "+s"(l_)); unsigned char* w_ = args.ws; asm volatile("" : "+s"(w_)); int t_ = threadIdx.x; asm volatile("" : "+v"(t_)); xcd_barrier((unsigned*)(w_ + WS_CTL), (volatile LAS unsigned*)(l_ + LDS_MISC), __builtin_amdgcn_readfirstlane(t_ >> 6), t_ & 63); } while (0)
    if (threadIdx.x < 16) ((volatile LAS unsigned*)((LAS unsigned char*)lds + LDS_MISC))[threadIdx.x] = 0u;
    __syncthreads();
    for (int l = 0; l < DEPTH; ++l) {
#ifndef NO_PRO
        { PHASE_PTRS MKFRAME
        prologue(F, args, l); }
#endif
        if (gridDim.y > 1) grid.sync(); else GSYNC();
        {   PHASE_PTRS
            pg8::Gemm g{XB, (const bf16*)(ws + WS_W1A), M, 2 * FFH, DM, DM, DM}; pg8::StaticOrder S; S.init(M, 2 * FFH, G_, bx_);
            EpiSwiglu E{ACT, SSQ};
            pg8::gemm_phase<EpiSwiglu, pg8::StaticOrder, true, true>(ldsp, g, S, E);
            pg8::Gemm g2{(const bf16*)(ws + WS_MEMN), (const bf16*)(ws + WS_WKV), MROWS, 2 * DM, DM, DM, DM}; pg8::StaticOrder S2; S2.init(MROWS, 2 * DM, G_, bx_ >= 128 ? bx_ - 128 : (1 << 28));
            EpiPlain E2{(bf16*)(ws + WS_KV), 2 * DM, nullptr, 1.f};
            pg8::gemm_phase<EpiPlain, pg8::StaticOrder, true, true>(ldsp, g2, S2, E2);
        }
        GSYNC();
        {   PHASE_PTRS
            pg8::Gemm g{ACT, (const bf16*)(ws + WS_W1B), M, DM, FFH, FFH, FFH}; pg8::StaticOrder S; S.init(M, DM, G_, bx_);
            EpiRes E{XB, SSQ, 0.5f};
            pg8::gemm_phase<EpiRes, pg8::StaticOrder, true, true>(ldsp, g, S, E);
        }
        GSYNC();
        {   PHASE_PTRS
            pg8::Gemm g{XB, (const bf16*)(ws + WS_WIN), M, NINP, DM, DM, DM}; pg8::StaticOrder S; S.init(M, NINP, G_, bx_);
            EpiWin E{ws, (const float*)(ws + WS_LB) + l * 512, args.in[10] + l * 8};
            pg8::gemm_phase<EpiWin, pg8::StaticOrder, true, true>(ldsp, g, S, E);
        }
        {   PHASE_PTRS
            int kf_ = 256; asm volatile("" : "+s"(kf_));
            { pg8::Gemm gA{(const bf16*)(ws + WS_KV), (const bf16*)(ws + WS_WQ), 256, 256, kf_, 2 * DM, DM}; pg8::FoldOrder SA{bx_ - 192, false}; EpiFold EA{(bf16*)(ws + WS_WQK), false, 0.0625f};
              pg8::gemm_phase<EpiFold, pg8::FoldOrder, true, true>(ldsp, gA, SA, EA); }
            { pg8::Gemm gB{(const bf16*)(ws + WS_WO), (const bf16*)(ws + WS_KV), 256, 256, kf_, DM, 2 * DM}; pg8::FoldOrder SB{bx_ - 224, true}; EpiFold EB{(bf16*)(ws + WS_VWO), true, 1.f};
              pg8::gemm_phase<EpiFold, pg8::FoldOrder, true, true>(ldsp, gB, SB, EB); }
        }
        GSYNC();
        { PHASE_PTRS MKFRAME
          for (int u = F.vcu; u < 1024 + 16; u += F.G) { if (u < 1024) hgrn_pass1_unit(F, u); else fox_cumsum_unit(F, u - 1024); } }
        GSYNC();
        { PHASE_PTRS MKFRAME fox_bounds(F); hgrn_pass2(F); }
        GSYNC();
        { PHASE_PTRS MKFRAME for (int u = F.vcu; u < 512; u += F.G) hgrn_pass3_unit(F, args.in[9] + l * 128, u); }
        {   PHASE_PTRS
            const attn_body::AttnTensors AT{(const attn_body::bf16*)(ws + WS_QO) + 512, (const attn_body::bf16*)(ws + WS_FK), (const attn_body::bf16*)(ws + WS_FV), (attn_body::bf16*)(ws + WS_QO) + 512, (const float*)(ws + WS_C2), (const float*)(ws + WS_KMAX), (const float*)(ws + WS_QS)};
            const attn_body::StaticOrder S(G_, bx_, (const int*)(ws + WS_ORD));
            attn_body::attn_phase<attn_body::StaticOrder>((char*)ldsp, AT, S);
        }
        GSYNC();
        {   PHASE_PTRS
            pg8::Gemm g{(const bf16*)(ws + WS_QO), (const bf16*)(ws + WS_WOUT), M, DM, DM, DM, DM}; pg8::StaticOrder S; S.init(M, DM, G_, bx_);
            EpiRes E{XB, SSQ, 1.0f};
            pg8::gemm_phase<EpiRes, pg8::StaticOrder, true, true>(ldsp, g, S, E);
        }
        GSYNC();
        {   PHASE_PTRS
            pg8::Gemm g{XB, (const bf16*)(ws + WS_WQK), M, DM, DM, DM, DM}; pg8::BatchOrder S; S.init(M, DM, G_, bx_); S.mb = SEQ / 256; S.bstride = (size_t)DM * DM * 2;
            EpiSoftmax E{(bf16*)(ws + WS_PB), SSQ, (LAS float*)(ldsp + 131072)};
            pg8::gemm_phase<EpiSoftmax, pg8::BatchOrder, true, true>(ldsp, g, S, E);
        }
        GSYNC();
        {   PHASE_PTRS
            pg8::Gemm g{(const bf16*)(ws + WS_PB), (const bf16*)(ws + WS_VWO), M, DM, DM, DM, DM}; pg8::BatchOrder S; S.init(M, DM, G_, bx_); S.mb = SEQ / 256; S.bstride = (size_t)DM * DM * 2;
            EpiRes E{XB, SSQ, 1.0f};
            pg8::gemm_phase<EpiRes, pg8::BatchOrder, true, true>(ldsp, g, S, E);
        }
        GSYNC();
        {   PHASE_PTRS
            pg8::Gemm g{XB, (const bf16*)(ws + WS_W2A), M, 2 * FFH, DM, DM, DM}; pg8::StaticOrder S; S.init(M, 2 * FFH, G_, bx_);
            EpiSwiglu E{ACT, SSQ};
            pg8::gemm_phase<EpiSwiglu, pg8::StaticOrder, true, true>(ldsp, g, S, E);
        }
        GSYNC();
        {   PHASE_PTRS
            pg8::Gemm g{ACT, (const bf16*)(ws + WS_W2B), M, DM, FFH, FFH, FFH}; pg8::StaticOrder S; S.init(M, DM, G_, bx_);
            EpiRes E{XB, SSQ, 0.5f};
            pg8::gemm_phase<EpiRes, pg8::StaticOrder, true, true>(ldsp, g, S, E);
        }
        GSYNC();
    }
    { PHASE_PTRS MKFRAME
    final_norm(F, args.in[22]); }
}

extern "C" void kernel_launch(void* const* d_in, const int* in_sizes, int n_in, void* d_out, int out_size, void* d_ws, size_t ws_size, hipStream_t stream) {
    static int grid = 0;
    if (grid == 0) {
        if (n_in != 23 || out_size != M * DM || ws_size < WS_END3) { fprintf(stderr, "kernel_launch: unexpected shapes n_in %d out %d ws %zu\n", n_in, out_size, ws_size); grid = -1; return; }
        int dev = 0, cus = 0, per_cu = 0;
        hipGetDevice(&dev); hipDeviceGetAttribute(&cus, hipDeviceAttributeMultiprocessorCount, dev);
        hipFuncSetAttribute((const void*)mega_fwd, hipFuncAttributeMaxDynamicSharedMemorySize, LDS_BYTES);
        hipOccupancyMaxActiveBlocksPerMultiprocessor(&per_cu, (const void*)mega_fwd, NTHREADS, LDS_BYTES);
        (void)hipGetLastError();
        if (per_cu < 1) per_cu = 1;
        grid = cus;
    }
    if (grid < 0) return;
    if (hipMemsetAsync((char*)d_ws + WS_CTL, 0, CTL_BYTES, stream) != hipSuccess) { fprintf(stderr, "kernel_launch: memset of the barrier words failed\n"); return; }
    Args a{};
    for (int i = 0; i < 23; ++i) a.in[i] = (const float*)d_in[i];
    a.out = (float*)d_out; a.ws = (unsigned char*)d_ws;
    void* kargs[] = {&a};
    hipError_t e = hipLaunchCooperativeKernel((const void*)mega_fwd, dim3(grid), dim3(NTHREADS), kargs, LDS_BYTES, stream);
    if (e != hipSuccess) fprintf(stderr, "cooperative launch failed: %s (grid %d)\n", hipGetErrorString(e), grid);
}
```

```cpp
#include <hip/hip_runtime.h>
#include <hip/hip_cooperative_groups.h>
#include <cstdio>
#include <cstdint>
namespace cg = cooperative_groups;
namespace pg8 {
#define PG8_LAS __attribute__((address_space(3)))
typedef unsigned short bf16_t;
typedef short bf16x8 __attribute__((ext_vector_type(8)));
typedef float f32x4 __attribute__((ext_vector_type(4)));
typedef unsigned u32x4 __attribute__((ext_vector_type(4)));
constexpr int BM = 256, BK = 64, HALF = 128, HTB = HALF * BK * 2  , STAGE_BYTES = 8 * HTB, NXCD = 8, WGM = 8;

__host__ __device__ __forceinline__ int lds_byte(int r, int c) { const int st = (r >> 4) * 2 + (c >> 5), rr = r & 15, cc = c & 31, ob = rr * 64 + cc * 2; return st * 1024 + (ob ^ (((ob >> 9) & 1) << 5)); }
__host__ __device__ __forceinline__ void stage_rc(int b, int& R, int& C) { const int st = b / 1024, sb = b % 1024, swz = sb ^ (((sb >> 9) & 1) << 5); R = (st >> 1) * 16 + swz / 64; C = (st & 1) * 32 + (swz % 64) / 2; }
__host__ __device__ __forceinline__ int perm32(int rho) { const int n = rho >> 4, i = rho & 15; return 8 * (i >> 2) + 4 * n + (i & 3); }

struct Unit { int pm, pn; };
struct Gemm { const bf16_t* A; const bf16_t* Bt; int M, N, K, lda, ldb; };

struct StaticOrder {
    int nM, nN, nwg, G, c;
    __host__ __device__ void init(int M, int N, int G_, int c_) { nM = M / BM; nN = N / BM; nwg = nM * nN; G = G_; c = c_; }
    __host__ __device__ bool next(int i, Unit& u) const {
        const long L = (long)i * G + c; if (L >= nwg) return false;
        int wgid = (int)L; { const int q = nwg / NXCD, r = nwg % NXCD, xcd = wgid % NXCD, off = wgid / NXCD; wgid = (xcd < r ? xcd * (q + 1) : r * (q + 1) + (xcd - r) * q) + off; }
        const int nig = WGM * nN, gid = wgid / nig, fm = gid * WGM, gsz = (nM - fm) < WGM ? (nM - fm) : WGM;
        u.pm = fm + ((wgid % nig) % gsz); u.pn = (wgid % nig) / gsz; return true;
    }
    __device__ __forceinline__ void a_ready(const Unit&) const {}
    __device__ __forceinline__ void done(const Unit&) const {}
    __device__ __forceinline__ size_t aoff(const Unit& u, size_t tstep) const { return (size_t)u.pm * tstep; }
    __device__ __forceinline__ size_t boff(const Unit& u, size_t tstep) const { return (size_t)u.pn * tstep; }
};
struct BatchOrder : StaticOrder { int mb; size_t bstride;
    __device__ __forceinline__ size_t boff(const Unit& u, size_t tstep) const { return (size_t)u.pn * tstep + (u.pm >= mb ? bstride : 0); } };
struct FoldOrder { int j; bool modeB;
    __device__ __forceinline__ bool next(int i, Unit& u) const { if (i > 0 || j < 0 || j >= 32) return false; u.pm = j; u.pn = 0; return true; }
    __device__ __forceinline__ void a_ready(const Unit&) const {}
    __device__ __forceinline__ void done(const Unit&) const {}
    __device__ __forceinline__ size_t aoff(const Unit& u, size_t) const { const int hd = u.pm >> 3, b = (u.pm >> 2) & 1, q = u.pm & 3; return modeB ? ((size_t)q * 256 * 1024 + hd * 256) * 2 : ((size_t)b * 256 * 2048 + hd * 256) * 2; }
    __device__ __forceinline__ size_t boff(const Unit& u, size_t) const { const int hd = u.pm >> 3, b = (u.pm >> 2) & 1, q = u.pm & 3; return modeB ? ((size_t)b * 256 * 2048 + 1024 + hd * 256) * 2 : ((size_t)q * 256 * 1024 + hd * 256) * 2; }
};

typedef float f32x2cv __attribute__((ext_vector_type(2))); typedef __bf16 bf16x2cv __attribute__((ext_vector_type(2)));
__device__ __forceinline__ unsigned cvt_pk_bf16(float lo, float hi) { const f32x2cv v = {lo, hi}; const bf16x2cv b = __builtin_convertvector(v, bf16x2cv); return __builtin_bit_cast(unsigned, b); }
template <class Epi, class Sched, bool ALIGN_EPI = false, bool SP2 = false>
__device__ __forceinline__ void gemm_phase(PG8_LAS unsigned char* lds, const Gemm g, const Sched& S, const Epi& E) {
    int tid_ = threadIdx.x; asm volatile("" : "+v"(tid_)); const int tid = tid_, wid = __builtin_amdgcn_readfirstlane(tid >> 6), lane = tid & 63, wr = wid >> 2, wc = wid & 3, fr = lane & 15, fq = lane >> 4;
    const int K = g.K, nt = K / BK;
    unsigned voffA[2], voffB[2];
#pragma unroll
    for (int i = 0; i < 2; ++i) { int R, C; stage_rc(tid * 16 + i * 8192, R, C); const int Rb = Epi::PERM ? ((R & ~31) + perm32(R & 31)) : R;
        voffA[i] = (unsigned)(R * g.lda + C) * 2u; voffB[i] = (unsigned)(Rb * g.ldb + C) * 2u; }
    const size_t kstep = (size_t)(BK * 2);
    const size_t hstepA = (size_t)HALF * g.lda * 2, hstepB = (size_t)HALF * g.ldb * 2;
    const size_t tstepA = 2 * hstepA, tstepB = 2 * hstepB;
    const unsigned ldsw = (unsigned)wid * 1024u;
    const int aoff = lds_byte(wr * 64 + fr, fq * 8), boff = lds_byte(wc * 32 + fr, fq * 8);
#define PG8_SA(b, h) (((b) * 2 + (h)) * HTB)
#define PG8_SB(b, h) ((4 + (b) * 2 + (h)) * HTB)
#define PG8_STAGE(bufoff, gbase, voff) do { _Pragma("unroll") for (int _i = 0; _i < 2; ++_i) \
        __builtin_amdgcn_global_load_lds((const unsigned*)((const char*)(gbase) + (voff)[_i]), (PG8_LAS unsigned*)(lds + (bufoff) + ldsw + _i * 8192), 16, 0, 0); } while (0)
#define PG8_LDA(dst, b, h) do { _Pragma("unroll") for (int m = 0; m < 4; ++m) _Pragma("unroll") for (int k = 0; k < 2; ++k) dst[m][k] = *(const PG8_LAS bf16x8*)(lds + PG8_SA(b, h) + aoff + m * 2048 + k * 1024); } while (0)
#define PG8_LDB(dst, b, h) do { _Pragma("unroll") for (int n = 0; n < 2; ++n) _Pragma("unroll") for (int k = 0; k < 2; ++k) dst[n][k] = *(const PG8_LAS bf16x8*)(lds + PG8_SB(b, h) + boff + n * 2048 + k * 1024); } while (0)
#define PG8_MMA(ai, bj, At, Bt) do { __builtin_amdgcn_s_setprio(1); _Pragma("unroll") for (int m = 0; m < 4; ++m) _Pragma("unroll") for (int n = 0; n < 2; ++n) _Pragma("unroll") for (int k = 0; k < 2; ++k) \
        acc[ai][bj][m][n] = __builtin_amdgcn_mfma_f32_16x16x32_bf16(Bt[n][k], At[m][k], acc[ai][bj][m][n], 0, 0, 0); __builtin_amdgcn_s_setprio(0); } while (0)
#define PG8_WAIT_V(n) asm volatile("s_waitcnt vmcnt(" #n ")" ::: "memory")
#define PG8_WAIT_L(n) asm volatile("s_waitcnt lgkmcnt(" #n ")" ::: "memory")
#define PG8_BAR __builtin_amdgcn_s_barrier()
#define PG8_SCHED __builtin_amdgcn_sched_barrier(0)
    Unit cur, nxt; int ui = 0;
    if (!S.next(0, cur)) return;
    f32x4 acc[2][2][4][2];
#pragma unroll
    for (int a = 0; a < 2; ++a)
#pragma unroll
        for (int b = 0; b < 2; ++b)
#pragma unroll
            for (int m = 0; m < 4; ++m)
#pragma unroll
                for (int n = 0; n < 2; ++n) acc[a][b][m][n] = (f32x4){0.f, 0.f, 0.f, 0.f};
    bf16x8 At[4][2], B0[2][2], B1[2][2];
    const char* cA = (const char*)g.A + S.aoff(cur, tstepA); const char* cB = (const char*)g.Bt + S.boff(cur, tstepB);
    S.a_ready(cur);
    if constexpr (SP2) {
        PG8_STAGE(PG8_SB(0, 0), cB, voffB); PG8_STAGE(PG8_SB(0, 1), cB + hstepB, voffB); PG8_STAGE(PG8_SA(0, 0), cA, voffA); PG8_STAGE(PG8_SA(0, 1), cA + hstepA, voffA);
        if (wr == 1) PG8_BAR;
        PG8_WAIT_V(2); PG8_BAR;
        PG8_STAGE(PG8_SB(1, 0), cB + kstep, voffB); PG8_STAGE(PG8_SA(1, 0), cA + kstep, voffA); PG8_STAGE(PG8_SB(1, 1), cB + hstepB + kstep, voffB);
        PG8_WAIT_V(6); PG8_BAR;
    } else {
        PG8_STAGE(PG8_SB(0, 0), cB, voffB); PG8_STAGE(PG8_SA(0, 0), cA, voffA); PG8_STAGE(PG8_SB(0, 1), cB + hstepB, voffB); PG8_STAGE(PG8_SA(0, 1), cA + hstepA, voffA);
        if (wr == 1) PG8_BAR;
        PG8_WAIT_V(4); PG8_BAR;
        PG8_STAGE(PG8_SB(1, 0), cB + kstep, voffB); PG8_STAGE(PG8_SA(1, 0), cA + kstep, voffA); PG8_STAGE(PG8_SB(1, 1), cB + hstepB + kstep, voffB);
        PG8_WAIT_V(6); PG8_BAR;
    }
    for (;;) {
        const bool has_next = S.next(ui + 1, nxt);
        const char* nA = has_next ? (const char*)g.A + S.aoff(nxt, tstepA) : cA; const char* nB = has_next ? (const char*)g.Bt + S.boff(nxt, tstepB) : cB;
        for (int t = 0; t < nt; t += 2) {
            const bool last = (t == nt - 2);
            const char* a1 = cA + (size_t)(t + 1) * kstep;
            const char* a2 = last ? nA : cA + (size_t)(t + 2) * kstep; const char* b2 = last ? nB : cB + (size_t)(t + 2) * kstep;
            const char* a3 = a2 + kstep; const char* b3 = b2 + kstep;
            if (last && has_next) S.a_ready(nxt);
            if constexpr (SP2) {
            PG8_LDB(B0, 0, 0); PG8_LDB(B1, 0, 1); PG8_SCHED; PG8_LDA(At, 0, 0); PG8_STAGE(PG8_SA(1, 1), a1 + hstepA, voffA);
            PG8_WAIT_V(8); PG8_WAIT_L(0); PG8_BAR; PG8_MMA(0, 0, At, B0); PG8_MMA(0, 1, At, B1); PG8_BAR; PG8_SCHED;
            PG8_LDA(At, 0, 1); PG8_STAGE(PG8_SB(0, 0), b2, voffB); PG8_STAGE(PG8_SB(0, 1), b2 + hstepB, voffB); PG8_STAGE(PG8_SA(0, 0), a2, voffA);
            PG8_WAIT_V(8); PG8_WAIT_L(0); PG8_BAR; PG8_MMA(1, 0, At, B0); PG8_MMA(1, 1, At, B1); PG8_BAR; PG8_SCHED;
            PG8_LDB(B0, 1, 0); PG8_LDB(B1, 1, 1); PG8_SCHED; PG8_LDA(At, 1, 0); PG8_STAGE(PG8_SA(0, 1), a2 + hstepA, voffA);
            PG8_WAIT_V(8); PG8_WAIT_L(0); PG8_BAR; PG8_MMA(0, 0, At, B0); PG8_MMA(0, 1, At, B1); PG8_BAR; PG8_SCHED;
            PG8_LDA(At, 1, 1); PG8_STAGE(PG8_SB(1, 0), b3, voffB); PG8_STAGE(PG8_SB(1, 1), b3 + hstepB, voffB); PG8_STAGE(PG8_SA(1, 0), a3, voffA);
            PG8_WAIT_V(8); PG8_WAIT_L(0); PG8_BAR; PG8_MMA(1, 0, At, B0); PG8_MMA(1, 1, At, B1); PG8_BAR; PG8_SCHED;
            } else {
            PG8_LDB(B0, 0, 0); PG8_SCHED; PG8_LDA(At, 0, 0); PG8_STAGE(PG8_SA(1, 1), a1 + hstepA, voffA);
            PG8_WAIT_L(8); PG8_BAR; PG8_WAIT_L(0); PG8_MMA(0, 0, At, B0); PG8_BAR; PG8_SCHED;
            PG8_LDB(B1, 0, 1); PG8_STAGE(PG8_SB(0, 0), b2, voffB);
            PG8_BAR; PG8_WAIT_L(0); PG8_MMA(0, 1, At, B1); PG8_BAR;
            PG8_LDA(At, 0, 1); PG8_STAGE(PG8_SA(0, 0), a2, voffA);
            PG8_BAR; PG8_WAIT_L(0); PG8_MMA(1, 0, At, B0); PG8_BAR; PG8_SCHED;
            PG8_STAGE(PG8_SB(0, 1), b2 + hstepB, voffB);
            PG8_WAIT_V(6); PG8_BAR; PG8_MMA(1, 1, At, B1); PG8_BAR;
            PG8_LDB(B0, 1, 0); PG8_SCHED; PG8_LDA(At, 1, 0); PG8_STAGE(PG8_SA(0, 1), a2 + hstepA, voffA);
            PG8_WAIT_L(8); PG8_BAR; PG8_WAIT_L(0); PG8_MMA(0, 0, At, B0); PG8_BAR; PG8_SCHED;
            PG8_LDB(B1, 1, 1); PG8_STAGE(PG8_SB(1, 0), b3, voffB);
            PG8_BAR; PG8_WAIT_L(0); PG8_MMA(0, 1, At, B1); PG8_BAR;
            PG8_LDA(At, 1, 1); PG8_STAGE(PG8_SA(1, 0), a3, voffA);
            PG8_BAR; PG8_WAIT_L(0); PG8_MMA(1, 0, At, B0); PG8_BAR; PG8_SCHED;
            PG8_STAGE(PG8_SB(1, 1), b3 + hstepB, voffB);
            PG8_WAIT_V(6); PG8_BAR; PG8_MMA(1, 1, At, B1); PG8_BAR;
            }
        }
        if constexpr (ALIGN_EPI) { if (wr == 0) PG8_BAR; }
        if constexpr (!Epi::AFTER_DRAIN) { E(acc, cur, wr, wc, fr, fq); S.done(cur); }
        if (!has_next) break;
#pragma unroll
        for (int a = 0; a < 2; ++a)
#pragma unroll
            for (int b = 0; b < 2; ++b)
#pragma unroll
                for (int m = 0; m < 4; ++m)
#pragma unroll
                    for (int n = 0; n < 2; ++n) acc[a][b][m][n] = (f32x4){0.f, 0.f, 0.f, 0.f};
        cur = nxt; cA = nA; cB = nB; ++ui;
        if constexpr (ALIGN_EPI) { if (wr == 1) PG8_BAR; }
    }
    PG8_WAIT_V(0);
    if constexpr (!ALIGN_EPI) { if (wr == 0) PG8_BAR; }
    PG8_BAR;
    if constexpr (Epi::AFTER_DRAIN) { E.fused(acc, cur, wr, wc, fr, fq, lds, wid, lane); S.done(cur); }
#undef PG8_SA
#undef PG8_SB
#undef PG8_STAGE
#undef PG8_LDA
#undef PG8_LDB
#undef PG8_MMA
#undef PG8_WAIT_V
#undef PG8_WAIT_L
#undef PG8_BAR
#undef PG8_SCHED
}
}
#include <hip/hip_bf16.h>
namespace attn_body {
using bf16=__hip_bfloat16;
using bf16x8=__attribute__((ext_vector_type(8)))short;
using s16x4=__attribute__((ext_vector_type(4)))short;
using f32x16=__attribute__((ext_vector_type(16)))float;
using u32x4=__attribute__((ext_vector_type(4)))unsigned;
constexpr int BATCH=2,NHEAD=8,SEQ=8192,D=64,QP=1024,KP=512;
constexpr int NW=8,QBLK=32,QB=QBLK*NW,KVBLK=64,NQB=SEQ/QB;
constexpr int ATTN_UNIT_ROWS=QB;
__device__ __forceinline__ int crow(int r,int hi){return (r&3)+8*(r>>2)+4*hi;}
#define SBAR() __builtin_amdgcn_sched_barrier(0)
__device__ __forceinline__ void cmask(f32x16&p0,f32x16&p1,int jb,int qrel,int hi){
  const float NEG=-INFINITY; int kb=64*jb+4*hi;
  #pragma unroll
  for(int r=0;r<16;++r){int kv=kb+(r&3)+8*(r>>2); if(kv>qrel)p0[r]=NEG; if(kv+32>qrel)p1[r]=NEG;}
}

constexpr int NSLOT=3, SLOTB=8192;
constexpr int LDS_K=0, LDS_V=NSLOT*SLOTB, LDS_WS=2*NSLOT*SLOTB, LDS_OST=LDS_WS+NW*64*4, LDS_CK=LDS_OST+NW*4096, LDS_BYTES=LDS_CK+SEQ*4;
constexpr float C2=0.125f*1.4426950408889634f;
__device__ __forceinline__ void glds16(const void*gsrc,unsigned lds_dst){unsigned keep;
  asm volatile("s_mov_b32 %0, m0\n\ts_mov_b32 m0, %2\n\ts_nop 0\n\tglobal_load_lds_dwordx4 %1, off\n\ts_mov_b32 m0, %0":"=&s"(keep):"v"(gsrc),"s"(lds_dst):"memory");}
__device__ __forceinline__ float max3f(float a,float b,float c){float r;asm("v_max3_f32 %0, %1, %2, %3":"=v"(r):"v"(a),"v"(b),"v"(c));return r;}
__device__ __forceinline__ float max2f(float a,float b){float r;asm("v_max_f32_e32 %0, %1, %2":"=v"(r):"v"(a),"v"(b));return r;}
__device__ __forceinline__ float fadd_s(float a,float b){float r;asm("v_add_f32_e32 %0, %1, %2":"=v"(r):"v"(a),"v"(b));return r;}
__device__ __forceinline__ float fsub_s(float a,float b){float r;asm("v_sub_f32_e32 %0, %1, %2":"=v"(r):"v"(a),"v"(b));return r;}
typedef float f32x2_t __attribute__((ext_vector_type(2))); typedef __bf16 bf16x2_t __attribute__((ext_vector_type(2)));
__device__ __forceinline__ unsigned cvtpk_s(float lo,float hi){f32x2_t v={lo,hi};bf16x2_t b=__builtin_convertvector(v,bf16x2_t);return __builtin_bit_cast(unsigned,b);}
#define WAIT_BAR(N) asm volatile("s_waitcnt vmcnt(" #N ") lgkmcnt(0)\n\ts_barrier":::"memory")

__device__ __forceinline__ void qkt(f32x16&p0,f32x16&p1,const char*Kslot,const bf16x8*qr,const f32x16&negm,int r32,int hi){
  const char*kb=Kslot+hi*1024+r32*16;
  #pragma unroll
  for(int d0=0;d0<4;++d0){
    const bf16x8 b0=*reinterpret_cast<const bf16x8*>(kb+d0*2048);
    const bf16x8 b1=*reinterpret_cast<const bf16x8*>(kb+d0*2048+512);
    if(d0==0){p0=__builtin_amdgcn_mfma_f32_32x32x16_bf16(b0,qr[0],negm,0,0,0);p1=__builtin_amdgcn_mfma_f32_32x32x16_bf16(b1,qr[0],negm,0,0,0);}
    else{p0=__builtin_amdgcn_mfma_f32_32x32x16_bf16(b0,qr[d0],p0,0,0,0);p1=__builtin_amdgcn_mfma_f32_32x32x16_bf16(b1,qr[d0],p1,0,0,0);}}
}
typedef __attribute__((address_space(3))) const char* lds_cptr;
typedef short v4i16_t __attribute__((ext_vector_type(4)));
__device__ __forceinline__ void kload8(bf16x8*kf,lds_cptr kp){
  kf[0]=*(const __attribute__((address_space(3))) bf16x8*)(kp);      kf[1]=*(const __attribute__((address_space(3))) bf16x8*)(kp+512);
  kf[2]=*(const __attribute__((address_space(3))) bf16x8*)(kp+2048); kf[3]=*(const __attribute__((address_space(3))) bf16x8*)(kp+2560);
  kf[4]=*(const __attribute__((address_space(3))) bf16x8*)(kp+4096); kf[5]=*(const __attribute__((address_space(3))) bf16x8*)(kp+4608);
  kf[6]=*(const __attribute__((address_space(3))) bf16x8*)(kp+6144); kf[7]=*(const __attribute__((address_space(3))) bf16x8*)(kp+6656);
}
__device__ __forceinline__ void kload2(bf16x8*kf,lds_cptr kp,int j){ kf[2*j]=*(const __attribute__((address_space(3))) bf16x8*)(kp+j*2048); kf[2*j+1]=*(const __attribute__((address_space(3))) bf16x8*)(kp+j*2048+512); }
__device__ __forceinline__ s16x4 vtr(lds_cptr p){ return __builtin_bit_cast(s16x4,__builtin_amdgcn_ds_read_tr16_b64_v4i16((__attribute__((address_space(3))) v4i16_t*)p)); }
__device__ __forceinline__ float rowmax(const f32x16&p0,const f32x16&p1){
  float a=max3f(p0[0],p0[1],p1[0]),b=max3f(p0[2],p0[3],p1[1]);a=max3f(a,p1[2],p1[3]);
  #pragma unroll
  for(int r=4;r<16;r+=4){a=max3f(a,p0[r],p0[r+1]);b=max3f(b,p0[r+2],p0[r+3]);a=max3f(a,p1[r],p1[r+1]);b=max3f(b,p1[r+2],p1[r+3]);}
  const float m=max2f(a,b);
  auto rr=__builtin_amdgcn_permlane32_swap(__float_as_uint(m),__float_as_uint(m),false,false);
  return max2f(__uint_as_float(rr[0]),__uint_as_float(rr[1]));
}
__device__ __forceinline__ void pv(f32x16*o,int vb,bf16x8 pa0,bf16x8 pa1,bf16x8 pa2,bf16x8 pa3){
  #pragma unroll
  for(int d0=0;d0<2;++d0){s16x4 lo[4],hi[4];
    #pragma unroll
    for(int ks=0;ks<4;++ks){
      asm volatile("ds_read_b64_tr_b16 %0,%1 offset:%c2":"=&v"(lo[ks]):"v"(vb),"i"(d0*4096+ks*1024):"memory");
      asm volatile("ds_read_b64_tr_b16 %0,%1 offset:%c2":"=&v"(hi[ks]):"v"(vb),"i"(d0*4096+ks*1024+512):"memory");}
    asm volatile("s_waitcnt lgkmcnt(0)":::"memory");SBAR();
    #define PK(k) (bf16x8){lo[k][0],lo[k][1],lo[k][2],lo[k][3],hi[k][0],hi[k][1],hi[k][2],hi[k][3]}
    o[d0]=__builtin_amdgcn_mfma_f32_32x32x16_bf16(pa0,PK(0),o[d0],0,0,0);
    o[d0]=__builtin_amdgcn_mfma_f32_32x32x16_bf16(pa1,PK(1),o[d0],0,0,0);
    o[d0]=__builtin_amdgcn_mfma_f32_32x32x16_bf16(pa2,PK(2),o[d0],0,0,0);
    o[d0]=__builtin_amdgcn_mfma_f32_32x32x16_bf16(pa3,PK(3),o[d0],0,0,0);
    #undef PK
  }
}

#ifndef ATTN_STORE16
#define ATTN_STORE16(p,v) (*(u32x4*)(p)=(v))
#endif
template<int THRL> __device__ __forceinline__ void attn_unit(int b,int h,int qb,const bf16*Q,const bf16*__restrict__ K,const bf16*__restrict__ V,bf16*O,const float*__restrict__ CK,const float*__restrict__ KMX,const float*__restrict__ QSV,char*shm){
  int tid_=threadIdx.x; asm volatile("":"+v"(tid_)); const int tid=tid_,lane=tid&63,r32=lane&31,hi=lane>>5; const int wid=__builtin_amdgcn_readfirstlane(tid>>6);
  const long rowbase=(long)b*SEQ; const int q0=qb*QB;
  int ts;
  { const int NT0=(q0+QB)/KVBLK; const float qmx=QSV[0],smn=QSV[1];
    bool ns0=true,ns1=true;
    if(lane<NT0){ const float bd=qmx*KMX[lane]-CK[64*lane+63]-smn; ns0=!(bd<-40.f); }
    if(lane+64<NT0){ const float bd=qmx*KMX[lane+64]-CK[64*(lane+64)+63]-smn; ns1=!(bd<-40.f); }
    const unsigned long long m0=__ballot(ns0),m1=__ballot(ns1);
    int first=m0?__builtin_ctzll(m0):(m1?64+__builtin_ctzll(m1):128);
    first=first<NT0-4?first:NT0-4; ts=__builtin_amdgcn_readfirstlane(first&~1); }
  CK+=ts*KVBLK;
  const bf16*Qw=Q+(rowbase+q0+wid*QBLK)*QP+h*D;
  const bf16*Kh=K+(rowbase+(long)ts*KVBLK)*KP+h*D,*Vh=V+(rowbase+(long)ts*KVBLK)*KP+h*D;
  const unsigned lds0=(unsigned)(uintptr_t)shm;
  typedef __attribute__((address_space(3))) const float* lds_fptr; typedef float f32x4v __attribute__((ext_vector_type(4))); const __attribute__((address_space(3))) char* shm3f=(const __attribute__((address_space(3))) char*)shm;
  float*wsf=(float*)(shm+LDS_WS)+wid*64;
  const bf16*ksrc=Kh+(long)lane*KP+wid*8;
  const bf16*vsrc=Vh+(long)(16*(wid&3)+(lane>>2))*KP+(wid>>2)*32+(lane&3)*8;
  const unsigned kdst=lds0+LDS_K+wid*1024, vdst=lds0+LDS_V+wid*1024;
  #define DMA_K(t,slot) glds16(ksrc+(long)(t)*KVBLK*KP,(unsigned)__builtin_amdgcn_readfirstlane(kdst+(slot)))
  #define DMA_V(t,slot) glds16(vsrc+(long)(t)*KVBLK*KP,(unsigned)__builtin_amdgcn_readfirstlane(vdst+(slot)))
  const int vb0=(int)(lds0+LDS_V)+((lane>>4)&1)*32+(lane&3)*8+(4*hi+((lane&15)>>2))*64;
  const char*Kbase=shm+LDS_K; bf16x8 kf[8];
  const lds_cptr shm3=(lds_cptr)shm; const lds_cptr kp0=shm3+LDS_K+hi*1024+r32*16; const lds_cptr vp0=shm3+LDS_V+((lane>>4)&1)*32+(lane&3)*8+(4*hi+((lane&15)>>2))*64;
  const int NT=(q0+QB)/KVBLK-ts;
  { float*ckw=(float*)(shm+LDS_CK); const int nk4=NT*(KVBLK/4);
    for(int i=tid;i<nk4;i+=NW*64){ const f32x4v c4=*reinterpret_cast<const f32x4v*>(CK+4*i); *reinterpret_cast<f32x4v*>(ckw+4*i)=c4; } }
  const lds_fptr ckl=(lds_fptr)(shm3f+LDS_CK)+4*hi;
  #define LDC(p) (*(const __attribute__((address_space(3))) f32x4v*)(p))
  #define KBIAS(P0,P1,t) do{ _Pragma("unroll") for(int g_=0;g_<4;++g_){ const f32x4v c0_=*(const __attribute__((address_space(3))) f32x4v*)(ckl+(t)*64+8*g_), c1_=*(const __attribute__((address_space(3))) f32x4v*)(ckl+(t)*64+32+8*g_); \
      _Pragma("unroll") for(int i_=0;i_<4;++i_){ P0[4*g_+i_]-=c0_[i_]; P1[4*g_+i_]-=c1_[i_]; } } }while(0)
  DMA_K(0,0);DMA_V(0,0);DMA_K(1,SLOTB);
  bf16x8 qr[4];
  #pragma unroll
  for(int d0=0;d0<4;++d0)qr[d0]=*reinterpret_cast<const bf16x8*>(&Qw[(long)r32*QP+d0*16+hi*8]);
  float mhat=0.f,l_reg=0.f;f32x16 o[2];o[0]=f32x16{};o[1]=f32x16{};const f32x16 zero16=f32x16{};
  const int qrel=wid*QBLK+r32;
  #define CMASK(P0,P1,t) do{int jb_=(t)-(NT-4); if(jb_>=0)cmask(P0,P1,jb_,qrel,hi);}while(0)
  bool resc=false;
  #define START(P0,P1) do{ const float rm=rowmax(P0,P1); resc=false; \
    { const float dl=rm; mhat=fadd_s(mhat,dl); \
      _Pragma("unroll") for(int r=0;r<16;++r){P0[r]=fsub_s(P0[r],dl);P1[r]=fsub_s(P1[r],dl);} \
      } \
    _Pragma("unroll") for(int r=0;r<16;++r)P0[r]=__builtin_amdgcn_exp2f(P0[r]); }while(0)
  #define RESC() do{ if(resc){ asm volatile("s_waitcnt lgkmcnt(0)":::"memory"); \
      _Pragma("unroll") for(int d_=0;d_<2;++d_) _Pragma("unroll") for(int r=0;r<16;++r)o[d_][r]*=wsf[crow(r,hi)]; } }while(0)
  f32x16 pA0,pA1,pB0,pB1;
  int sl_prev=0,sl_cur=0,sl_next=SLOTB;
  #define ROT() do{sl_prev=sl_cur;sl_cur=sl_next;sl_next=(sl_next==(NSLOT-1)*SLOTB)?0:sl_next+SLOTB;}while(0)
  DMA_K(2,2*SLOTB);
  WAIT_BAR(3);
  qkt(pA0,pA1,Kbase,qr,zero16,r32,hi);asm volatile("s_nop 15\n\ts_nop 7":"+v"(pA0),"+v"(pA1));KBIAS(pA0,pA1,0);CMASK(pA0,pA1,0);
  START(pA0,pA1);
  _Pragma("unroll") for(int r=0;r<16;++r)pA1[r]=__builtin_amdgcn_exp2f(pA1[r]);
  { const float nm_=-mhat; _Pragma("unroll") for(int g_=0;g_<4;++g_){ const f32x4v c0_=LDC(ckl+64+8*g_), c1_=LDC(ckl+64+32+8*g_);
      _Pragma("unroll") for(int i_=0;i_<4;++i_){ pB0[4*g_+i_]=nm_-c0_[i_]; pB1[4*g_+i_]=nm_-c1_[i_]; } } }
  WAIT_BAR(0);
  DMA_K(3,0);DMA_V(1,SLOTB);
  ROT();
  kload8(kf,kp0+sl_cur);
  WAIT_BAR(2);
  s16x4 vlo[8],vhi[8]; u32x4 pw0,pw1,pw2,pw3;
  #define PKW(P,B) cvtpk_s(P[B],P[B+1])
  #define PAF(k) __builtin_bit_cast(bf16x8,pw##k)
  #define VFR(i) (bf16x8){vlo[i][0],vlo[i][1],vlo[i][2],vlo[i][3],vhi[i][0],vhi[i][1],vhi[i][2],vhi[i][3]}
  #define PIN(x) asm volatile("":"+v"(x))
  #define MX3(a,b,c) __builtin_fmaxf(__builtin_fmaxf((a),(b)),(c))
  #define GAPA(MF,A0,A1,A2,A3,W0,W1,PW) do{ MF; sacc+=A0; sacc+=A1; sacc+=A2; sacc+=A3; PIN(sacc); W0; W1; PIN(PW); SBAR(); }while(0)
  #define EX(v) __builtin_amdgcn_exp2f(v)
  #define GAPB(MF,X,B,PN,CN,NXT) do{ MF; X[B]=EX(X[B]); X[B+1]=EX(X[B+1]); X[B+2]=EX(X[B+2]); X[B+3]=EX(X[B+3]); PIN(X); \
      PN[B]=nm_-cpre_[0]; PN[B+1]=nm_-cpre_[1]; PN[B+2]=nm_-cpre_[2]; PN[B+3]=nm_-cpre_[3]; PIN(PN); cpre_=LDC(ckn_+(NXT)); SBAR(); }while(0)
  #define VRD(i) do{ vlo[i]=vtr(vp_+(((i)>>2)*4096+((i)&3)*1024)); vhi[i]=vtr(vp_+(((i)>>2)*4096+((i)&3)*1024+512)); }while(0)
  #define KRD(G,j) do{ if(G){ kload2(kf,kp0+sl_next,j); SBAR(); } }while(0)
  #define STEP(C0,C1,P0,P1,t,GK,GV,GL) do{ SBAR(); \
    const lds_cptr vp_=vp0+sl_prev; \
    VRD(0); SBAR(); float sacc=(P0[0]+P0[1]); \
    GAPA(C0=__builtin_amdgcn_mfma_f32_32x32x16_bf16(kf[0],qr[0],C0,0,0,0), P0[2],P0[3],P0[4],P0[5],     pw0[0]=PKW(P0,0), pw0[1]=PKW(P0,2), pw0); \
    VRD(4); SBAR(); GAPA(C1=__builtin_amdgcn_mfma_f32_32x32x16_bf16(kf[1],qr[0],C1,0,0,0), P0[6],P0[7],P0[8],P0[9],     pw0[2]=PKW(P0,4), pw0[3]=PKW(P0,6), pw0); \
    VRD(1); SBAR(); GAPA(C0=__builtin_amdgcn_mfma_f32_32x32x16_bf16(kf[2],qr[1],C0,0,0,0),   P0[10],P0[11],P0[12],P0[13], pw1[0]=PKW(P0,8), pw1[1]=PKW(P0,10), pw1); \
    VRD(5); SBAR(); GAPA(C1=__builtin_amdgcn_mfma_f32_32x32x16_bf16(kf[3],qr[1],C1,0,0,0),   P0[14],P0[15],P1[0],P1[1],   pw1[2]=PKW(P0,12),pw1[3]=PKW(P0,14), pw1); \
    VRD(2); SBAR(); GAPA(C0=__builtin_amdgcn_mfma_f32_32x32x16_bf16(kf[4],qr[2],C0,0,0,0),   P1[2],P1[3],P1[4],P1[5],     pw2[0]=PKW(P1,0), pw2[1]=PKW(P1,2), pw2); \
    VRD(6); SBAR(); GAPA(C1=__builtin_amdgcn_mfma_f32_32x32x16_bf16(kf[5],qr[2],C1,0,0,0),   P1[6],P1[7],P1[8],P1[9],     pw2[2]=PKW(P1,4), pw2[3]=PKW(P1,6), pw2); \
    VRD(3); SBAR(); GAPA(C0=__builtin_amdgcn_mfma_f32_32x32x16_bf16(kf[6],qr[3],C0,0,0,0),   P1[10],P1[11],P1[12],P1[13], pw3[0]=PKW(P1,8), pw3[1]=PKW(P1,10), pw3); \
    VRD(7); SBAR(); GAPA(C1=__builtin_amdgcn_mfma_f32_32x32x16_bf16(kf[7],qr[3],C1,0,0,0),   P1[14],P1[15],0.f,0.f,       pw3[2]=PKW(P1,12),pw3[3]=PKW(P1,14), pw3); \
    l_reg+=sacc; \
    if(GK){DMA_K((t)+3,sl_cur);} if(GV){DMA_V((t)+1,sl_next);} \
    CMASK(C0,C1,t); \
    { float a=MX3(C0[0],C0[1],C1[0]),b=MX3(C0[2],C0[3],C1[1]); a=MX3(a,C1[2],C1[3]); \
      _Pragma("unroll") for(int r=4;r<16;r+=4){a=MX3(a,C0[r],C0[r+1]);b=MX3(b,C0[r+2],C0[r+3]);a=MX3(a,C1[r],C1[r+1]);b=MX3(b,C1[r+2],C1[r+3]);} \
      float rm=__builtin_fmaxf(a,b); { auto rr=__builtin_amdgcn_permlane32_swap(__float_as_uint(rm),__float_as_uint(rm),false,false); rm=__builtin_fmaxf(__uint_as_float(rr[0]),__uint_as_float(rr[1])); } \
      resc=false; \
      if(__builtin_expect(__any(rm>(float)THRL),0)){ const float dl=__builtin_fmaxf(rm,0.f); mhat+=dl; \
        _Pragma("unroll") for(int r=0;r<16;++r){C0[r]-=dl;C1[r]-=dl;} \
        const float f=__builtin_amdgcn_exp2f(-dl); l_reg*=f; if(hi==0)wsf[r32]=f; resc=true; } } \
    const float nm_=-mhat; const lds_fptr ckn_=ckl+((t)+1)*64; f32x4v cpre_=LDC(ckn_); \
    SBAR(); \
    GAPB(o[0]=__builtin_amdgcn_mfma_f32_32x32x16_bf16(PAF(0),VFR(0),o[0],0,0,0), C0,0, P0,0,8); \
    GAPB(o[1]=__builtin_amdgcn_mfma_f32_32x32x16_bf16(PAF(0),VFR(4),o[1],0,0,0), C0,4, P0,4,16); \
    KRD(GL,0); GAPB(o[0]=__builtin_amdgcn_mfma_f32_32x32x16_bf16(PAF(1),VFR(1),o[0],0,0,0), C0,8, P0,8,24); \
    KRD(GL,1); GAPB(o[1]=__builtin_amdgcn_mfma_f32_32x32x16_bf16(PAF(1),VFR(5),o[1],0,0,0), C0,12, P0,12,32); \
    KRD(GL,2); GAPB(o[0]=__builtin_amdgcn_mfma_f32_32x32x16_bf16(PAF(2),VFR(2),o[0],0,0,0), C1,0, P1,0,40); \
    KRD(GL,3); GAPB(o[1]=__builtin_amdgcn_mfma_f32_32x32x16_bf16(PAF(2),VFR(6),o[1],0,0,0), C1,4, P1,4,48); \
    GAPB(o[0]=__builtin_amdgcn_mfma_f32_32x32x16_bf16(PAF(3),VFR(3),o[0],0,0,0), C1,8, P1,8,56); \
    GAPB(o[1]=__builtin_amdgcn_mfma_f32_32x32x16_bf16(PAF(3),VFR(7),o[1],0,0,0), C1,12, P1,12,56); \
    }while(0)
  int t=1;
  #undef CMASK
  #define CMASK(P0,P1,t) do{}while(0)
  for(;t+5<NT;t+=2){
    STEP(pB0,pB1,pA0,pA1,t,true,true,true);     WAIT_BAR(2); RESC(); ROT();
    STEP(pA0,pA1,pB0,pB1,t+1,true,true,true);   WAIT_BAR(2); RESC(); ROT();
  }
  #undef CMASK
  #define CMASK(P0,P1,t) do{int jb_=(t)-(NT-4); if(jb_>=0)cmask(P0,P1,jb_,qrel,hi);}while(0)
  #define ENDW(tt) do{ if((tt)+3<NT){WAIT_BAR(2);} else if((tt)+2<NT){WAIT_BAR(1);} else {WAIT_BAR(0);} }while(0)
  for(;t+1<NT;t+=2){
    STEP(pB0,pB1,pA0,pA1,t,(t+3<NT),(t+1<NT),(t+1<NT));       ENDW(t);   RESC(); ROT();
    STEP(pA0,pA1,pB0,pB1,t+1,(t+4<NT),(t+2<NT),(t+2<NT));     ENDW(t+1); RESC(); ROT();
  }
  STEP(pB0,pB1,pA0,pA1,NT-1,false,false,false); RESC();
  { float sacc=pB0[0]+pB0[1]; _Pragma("unroll") for(int r=2;r<16;++r)sacc+=pB0[r]; _Pragma("unroll") for(int r=0;r<16;++r)sacc+=pB1[r]; l_reg+=sacc;
    pw0=(u32x4){PKW(pB0,0),PKW(pB0,2),PKW(pB0,4),PKW(pB0,6)};pw1=(u32x4){PKW(pB0,8),PKW(pB0,10),PKW(pB0,12),PKW(pB0,14)};pw2=(u32x4){PKW(pB1,0),PKW(pB1,2),PKW(pB1,4),PKW(pB1,6)};pw3=(u32x4){PKW(pB1,8),PKW(pB1,10),PKW(pB1,12),PKW(pB1,14)};
    SBAR(); pv(o,vb0+sl_cur,PAF(0),PAF(1),PAF(2),PAF(3)); }
  #undef PKW
  #undef PAF
  #undef VFR
  #undef PIN
  #undef MX3
  #undef GAPA
  #undef GAPB
  #undef EX
  #undef VRD
  #undef KRD
  #undef STEP
  #undef ENDW
  {auto rr=__builtin_amdgcn_permlane32_swap(__float_as_uint(l_reg),__float_as_uint(l_reg),false,false);l_reg=__uint_as_float(rr[0])+__uint_as_float(rr[1]);}
  if(hi==0)wsf[32+r32]=l_reg;asm volatile("s_waitcnt lgkmcnt(0)":::"memory");
  float rli[16];
  #pragma unroll
  for(int r=0;r<16;++r)rli[r]=__builtin_amdgcn_rcpf(wsf[32+crow(r,hi)]);
  bf16*Ow=O+(rowbase+q0+wid*QBLK)*QP+h*D;
  { bf16*stg=(bf16*)(shm+LDS_OST)+wid*2048;
    #pragma unroll
    for(int r=0;r<16;++r){const int orow=crow(r,hi);
      #pragma unroll
      for(int d0=0;d0<2;++d0)stg[orow*64+d0*32+r32]=__float2bfloat16(o[d0][r]*rli[r]);}
    asm volatile("s_waitcnt lgkmcnt(0)":::"memory");
    #pragma unroll
    for(int i=0;i<4;++i){const int row=i*8+(lane>>3),ch=lane&7; const u32x4 v=*(const u32x4*)(stg+row*64+ch*8); ATTN_STORE16(Ow+(long)row*QP+ch*8,v);} }
  asm volatile("s_waitcnt lgkmcnt(0)\n\ts_barrier":::"memory");
  #undef KBIAS
  #undef LDC
  #undef DMA_K
  #undef DMA_V
  #undef CMASK
  #undef START
  #undef RESC
  #undef ROT
}
constexpr int ATTN_LDS_BYTES=LDS_BYTES;
struct AttnTensors { const bf16* Q; const bf16* K; const bf16* V; bf16* O; const float* CK; const float* KMAX; const float* QS; };
struct AttnUnit { int bh; int qb; };
struct StaticOrder {
  int vcu,G; const int* ORD;
  __device__ __forceinline__ explicit StaticOrder(int grid,int block,const int*ord):vcu((grid%8==0)?(block%8)*(grid/8)+block/8:block),G(grid),ORD(ord){}
  __device__ __forceinline__ bool next(int i,AttnUnit&u)const{ const int v=vcu+(i>>1)*G; if(v>=256)return false; const int s=v&15; u.bh=(G==256)?__builtin_amdgcn_readfirstlane(ORD[2*v+(i&1)]):(v>>4); u.qb=(i&1)?s:31-s; return true; }
  __device__ __forceinline__ void a_ready(const AttnUnit&)const{}
  __device__ __forceinline__ void done(const AttnUnit&)const{}
};
template<class Sched,int THRL=8> __device__ __forceinline__ void attn_phase(char*lds,const AttnTensors&T,const Sched&S){
  AttnUnit u;
  for(int i=0;S.next(i,u);++i){ S.a_ready(u); attn_unit<THRL>(u.bh/NHEAD,u.bh%NHEAD,u.qb,T.Q,T.K,T.V,T.O,T.CK+(long)u.bh*SEQ,T.KMAX+u.bh*(SEQ/KVBLK),T.QS+(u.bh*NQB+u.qb)*2,lds); S.done(u); }
}
#undef SBAR
#undef WAIT_BAR
}
constexpr int BATCH = 2, SEQ = 8192, DM = 1024, DEPTH = 2, NMEM = 256, M = BATCH * SEQ, FFH = 2816, NIN = 3592, NINP = 3840, MROWS = BATCH * NMEM;
constexpr float EPS = 1e-6f, LOG2E = 1.4426950408889634f, C2Q = 0.125f * 1.4426950408889634f;
constexpr int NWAVES = 8, NTHREADS = 512;
constexpr size_t MiB = 1u << 20;
constexpr size_t WS_W1A = 0, WS_W1B = 11 * MiB, WS_WIN = 33 * MiB / 2, WS_WOUT = 24 * MiB, WS_WQ = 26 * MiB, WS_WKV = 28 * MiB, WS_WO = 32 * MiB, WS_W2A = 34 * MiB, WS_W2B = 45 * MiB;
constexpr size_t WS_MEMN = 51 * MiB, WS_KV = 52 * MiB, WS_SSQ = 54 * MiB, WS_LB = 55 * MiB, WS_C2 = 55 * MiB + 65536, WS_FF = 56 * MiB, WS_XB = 58 * MiB;
constexpr size_t WS_ACT = 90 * MiB, WS_QO = 90 * MiB, WS_VH = 122 * MiB, WS_GH = 138 * MiB, WS_LF = 154 * MiB, WS_FK = 186 * MiB, WS_FV = 202 * MiB, WS_END = 218 * MiB;
constexpr size_t WS_PB = 90 * MiB, WS_WQK = 218 * MiB, WS_VWO = 222 * MiB, WS_END2 = 226 * MiB;
constexpr int LDS_BYTES = 147456;

#define GAS __attribute__((address_space(1)))
#define LAS __attribute__((address_space(3)))
typedef unsigned short bf16;
typedef unsigned v4u __attribute__((ext_vector_type(4)));
typedef unsigned v2u __attribute__((ext_vector_type(2)));
typedef float f32x4 __attribute__((ext_vector_type(4)));
using pg8::cvt_pk_bf16;
__device__ __forceinline__ float bf2f(unsigned short h) { return __uint_as_float(((unsigned)h) << 16); }
__device__ __forceinline__ float bflo(unsigned w) { return __uint_as_float(w << 16); }
__device__ __forceinline__ float bfhi(unsigned w) { return __uint_as_float(w & 0xffff0000u); }
__device__ __forceinline__ unsigned short f2bf(float f) { return (unsigned short)(cvt_pk_bf16(f, 0.f) & 0xffffu); }
__device__ __forceinline__ float wave_sum(float v) {
#pragma unroll
    for (int o = 1; o < 64; o <<= 1) v += __shfl_xor(v, o);
    return v;
}
__device__ __forceinline__ float wave_max(float v) {
#pragma unroll
    for (int o = 1; o < 64; o <<= 1) v = fmaxf(v, __shfl_xor(v, o));
    return v;
}
__device__ __forceinline__ float silu_f(float x) { return x * __builtin_amdgcn_rcpf(1.f + __expf(-x)); }
__device__ __forceinline__ float logsig_f(float x) { return fminf(x, 0.f) - __logf(1.f + __expf(-fabsf(x))); }

__device__ __forceinline__ float row_rstd(const float* ssq, int row, int fq) {
    const f32x4 v = *(const f32x4*)(ssq + (size_t)row * 16 + fq * 4);
    float s = (v[0] + v[1]) + (v[2] + v[3]);
    s += __shfl_xor(s, 16); s += __shfl_xor(s, 32);
    return __builtin_amdgcn_rsqf(s * (1.f / DM) + EPS);
}
__device__ __forceinline__ void row_rstd4(const float* ssq, int row0, int fq, float (&rs)[4]) {
    f32x4 v[4];
#pragma unroll
    for (int m = 0; m < 4; ++m) v[m] = *(const f32x4*)(ssq + (size_t)(row0 + m * 16) * 16 + fq * 4);
#pragma unroll
    for (int m = 0; m < 4; ++m) { float t = (v[m][0] + v[m][1]) + (v[m][2] + v[m][3]); t += __shfl_xor(t, 16); t += __shfl_xor(t, 32); rs[m] = __builtin_amdgcn_rsqf(t * (1.f / DM) + EPS); }
}
__device__ __forceinline__ v4u pack8(const f32x4 a, const f32x4 b) { v4u w; w.x = cvt_pk_bf16(a[0], a[1]); w.y = cvt_pk_bf16(a[2], a[3]); w.z = cvt_pk_bf16(b[0], b[1]); w.w = cvt_pk_bf16(b[2], b[3]); return w; }

struct EpiSwiglu {
    static constexpr bool PERM = true, AFTER_DRAIN = false;
    bf16* O; const float* ssq;
    __device__ __forceinline__ void operator()(const f32x4 (&acc)[2][2][4][2], const pg8::Unit& u, int wr, int wc, int fr, int fq) const {
        const int row0 = u.pm * 256 + wr * 64 + fr, col0 = u.pn * 128 + wc * 32 + 8 * fq;
#pragma unroll
        for (int ai = 0; ai < 2; ++ai) { float rsv[4]; row_rstd4(ssq, row0 + ai * 128, fq, rsv);
#pragma unroll
            for (int m = 0; m < 4; ++m) {
                const int row = row0 + ai * 128 + m * 16; const float rs = rsv[m], c = -rs * LOG2E, rs2 = rs * rs;
                f32x4 e0 = acc[ai][0][m][0] * c, e1 = acc[ai][0][m][1] * c;
#pragma unroll
                for (int i = 0; i < 4; ++i) { e0[i] = __builtin_amdgcn_exp2f(e0[i]); e1[i] = __builtin_amdgcn_exp2f(e1[i]); }
                e0 = e0 + 1.0f; e1 = e1 + 1.0f;
#pragma unroll
                for (int i = 0; i < 4; ++i) { e0[i] = __builtin_amdgcn_rcpf(e0[i]); e1[i] = __builtin_amdgcn_rcpf(e1[i]); }
                const f32x4 h0 = (acc[ai][0][m][0] * acc[ai][1][m][0]) * rs2 * e0, h1 = (acc[ai][0][m][1] * acc[ai][1][m][1]) * rs2 * e1;
                *(v4u*)(O + (size_t)row * FFH + col0) = pack8(h0, h1);
            } }
    }
};
struct EpiRes {
    static constexpr bool PERM = true, AFTER_DRAIN = false;
    bf16* xb; float* ssq; float alpha;
    __device__ __forceinline__ void operator()(const f32x4 (&acc)[2][2][4][2], const pg8::Unit& u, int wr, int wc, int fr, int fq) const {
        const int row0 = u.pm * 256 + wr * 64 + fr, col0 = u.pn * 256 + wc * 32 + 8 * fq;
#pragma unroll
        for (int ai = 0; ai < 2; ++ai)
#pragma unroll
            for (int m = 0; m < 4; ++m) {
                const int row = row0 + ai * 128 + m * 16; float ss = 0.f;
#pragma unroll
                for (int bj = 0; bj < 2; ++bj) {
                    const size_t off = (size_t)row * DM + col0 + bj * 128;
                    const v4u b = *(const v4u*)(xb + off);
                    f32x4 v0, v1; v0[0] = bflo(b.x); v0[1] = bfhi(b.x); v0[2] = bflo(b.y); v0[3] = bfhi(b.y); v1[0] = bflo(b.z); v1[1] = bfhi(b.z); v1[2] = bflo(b.w); v1[3] = bfhi(b.w);
                    v0 = v0 + alpha * acc[ai][bj][m][0]; v1 = v1 + alpha * acc[ai][bj][m][1];
                    const v4u w = pack8(v0, v1); *(v4u*)(xb + off) = w;
                    const float r0 = bflo(w.x), r1 = bfhi(w.x), r2 = bflo(w.y), r3 = bfhi(w.y), r4 = bflo(w.z), r5 = bfhi(w.z), r6 = bflo(w.w), r7 = bfhi(w.w);
                    ss += (r0 * r0 + r1 * r1) + (r2 * r2 + r3 * r3) + (r4 * r4 + r5 * r5) + (r6 * r6 + r7 * r7);
                }
                ss += __shfl_xor(ss, 16); ss += __shfl_xor(ss, 32);
                if (fq == 0) ssq[(size_t)row * 16 + u.pn * 4 + wc] = ss;
            }
    }
};
struct EpiPlain {
    static constexpr bool PERM = true, AFTER_DRAIN = false;
    bf16* O; int ldc; const float* ssq; float scale;
    __device__ __forceinline__ void operator()(const f32x4 (&acc)[2][2][4][2], const pg8::Unit& u, int wr, int wc, int fr, int fq) const {
        const int row0 = u.pm * 256 + wr * 64 + fr, col0 = u.pn * 256 + wc * 32 + 8 * fq;
#pragma unroll
        for (int ai = 0; ai < 2; ++ai)
#pragma unroll
            for (int m = 0; m < 4; ++m) {
                const int row = row0 + ai * 128 + m * 16; const float rs = (ssq ? row_rstd(ssq, row, fq) : 1.f) * scale;
#pragma unroll
                for (int bj = 0; bj < 2; ++bj) *(v4u*)(O + (size_t)row * ldc + col0 + bj * 128) = pack8(acc[ai][bj][m][0] * rs, acc[ai][bj][m][1] * rs);
            }
    }
};
struct EpiWin {
    static constexpr bool PERM = true, AFTER_DRAIN = false;
    unsigned char* wsb; const float* lb; const float* fbias;
    __device__ __forceinline__ void operator()(const f32x4 (&acc)[2][2][4][2], const pg8::Unit& u, int wr, int wc, int fr, int fq) const {
        const int row0 = u.pm * 256 + wr * 64 + fr, pn = (u.pn == 3) ? 13 : (u.pn == 13) ? 3 : (u.pn == 2) ? 12 : (u.pn == 12) ? 2 : u.pn, cw = wc * 32 + 8 * fq;
        bf16* const QO = (bf16*)(wsb + WS_QO); bf16* const VH = (bf16*)(wsb + WS_VH); bf16* const GH = (bf16*)(wsb + WS_GH); bf16* const FK = (bf16*)(wsb + WS_FK); bf16* const FV = (bf16*)(wsb + WS_FV);
        float* const LF = (float*)(wsb + WS_LF); float* const FF = (float*)(wsb + WS_FF); const float* const ssq = (const float*)(wsb + WS_SSQ);
        if (pn == 14) {
            if (wc == 0 && fq == 0) {
                const f32x4 fb0 = *(const f32x4*)fbias, fb1 = *(const f32x4*)(fbias + 4);
#pragma unroll
                for (int ai = 0; ai < 2; ++ai)
#pragma unroll
                    for (int m = 0; m < 4; ++m) {
                        const int row = row0 + ai * 128 + m * 16;
                        const f32x4 sv = *(const f32x4*)(ssq + (size_t)row * 16), sv1 = *(const f32x4*)(ssq + (size_t)row * 16 + 4), sv2 = *(const f32x4*)(ssq + (size_t)row * 16 + 8), sv3 = *(const f32x4*)(ssq + (size_t)row * 16 + 12);
                        const float st = ((sv[0] + sv[1]) + (sv[2] + sv[3])) + ((sv1[0] + sv1[1]) + (sv1[2] + sv1[3])) + ((sv2[0] + sv2[1]) + (sv2[2] + sv2[3])) + ((sv3[0] + sv3[1]) + (sv3[2] + sv3[3]));
                        const float rs = __builtin_amdgcn_rsqf(st * (1.f / DM) + EPS);
                        f32x4 a = acc[ai][0][m][0] * rs, b = acc[ai][0][m][1] * rs;
#pragma unroll
                        for (int i = 0; i < 4; ++i) { a[i] = logsig_f(a[i] + fb0[i]) * LOG2E; b[i] = logsig_f(b[i] + fb1[i]) * LOG2E; }
                        *(f32x4*)(FF + (size_t)row * 8) = a; *(f32x4*)(FF + (size_t)row * 8 + 4) = b;
                        asm volatile("" ::: "memory");
                    }
            }
            return;
        }
        const int grp = pn >> 1, cb = (pn & 1) * 256 + cw;
#define WIN_LOOP(...) _Pragma("unroll") for (int ai = 0; ai < 2; ++ai) { _Pragma("unroll") for (int m = 0; m < 4; ++m) { const int row = row0 + ai * 128 + m * 16; const float rs = row_rstd(ssq, row, fq); \
            _Pragma("unroll") for (int bj = 0; bj < 2; ++bj) { f32x4 a = acc[ai][bj][m][0] * rs, b = acc[ai][bj][m][1] * rs; const int c = cb + bj * 128; __VA_ARGS__ } } asm volatile("" ::: "memory"); }
        if (grp == 0) { WIN_LOOP( _Pragma("unroll") for (int i = 0; i < 4; ++i) { a[i] = silu_f(a[i]); b[i] = silu_f(b[i]); } *(v4u*)(QO + (size_t)row * DM + c) = pack8(a, b); ) }
        else if (grp == 3) { WIN_LOOP( _Pragma("unroll") for (int i = 0; i < 4; ++i) { a[i] = silu_f(a[i]); b[i] = silu_f(b[i]); } *(v4u*)(GH + (size_t)row * 512 + c) = pack8(a, b); ) }
        else if (grp == 1) {
            f32x4 l0[2], l1[2];
#pragma unroll
            for (int bj = 0; bj < 2; ++bj) { l0[bj] = *(const f32x4*)(lb + cb + bj * 128); l1[bj] = *(const f32x4*)(lb + cb + bj * 128 + 4); }
            WIN_LOOP( _Pragma("unroll") for (int i = 0; i < 4; ++i) { const float s0 = fminf(a[i], 0.f) - __logf(1.f + __expf(-fabsf(a[i]))), s1 = fminf(b[i], 0.f) - __logf(1.f + __expf(-fabsf(b[i]))); const float la = l0[bj][i], lbv = l1[bj][i];
                    a[i] = la > 0.f ? __logf(la + (1.f - la) * __expf(s0)) : s0; b[i] = lbv > 0.f ? __logf(lbv + (1.f - lbv) * __expf(s1)) : s1; }
                *(f32x4*)(LF + (size_t)row * 512 + c) = a; *(f32x4*)(LF + (size_t)row * 512 + c + 4) = b; __builtin_amdgcn_sched_barrier(0); ) }
        else if (grp == 2) { WIN_LOOP( *(v4u*)(VH + (size_t)row * 512 + c) = pack8(a, b); ) }
        else if (grp == 4) { WIN_LOOP( *(v4u*)(QO + (size_t)row * DM + 512 + c) = pack8(a * C2Q, b * C2Q); ) }
        else if (grp == 5) { WIN_LOOP( *(v4u*)(FK + (size_t)row * 512 + c) = pack8(a, b); ) }
        else { WIN_LOOP( *(v4u*)(FV + (size_t)row * 512 + c) = pack8(a, b); ) }
#undef WIN_LOOP
    }
};

struct EpiFold {
    static constexpr bool PERM = true, AFTER_DRAIN = false;
    bf16* O; bool modeB; float scale;
    __device__ __forceinline__ void operator()(const f32x4 (&acc)[2][2][4][2], const pg8::Unit& u, int wr, int wc, int fr, int fq) const {
        const int hd = u.pm >> 3, b = (u.pm >> 2) & 1, q = u.pm & 3;
        const int rowb = modeB ? q * 256 : b * 1024 + hd * 256, colb = modeB ? hd * 256 : q * 256; bf16* Ob = O + (modeB ? (size_t)b * 1024 * 1024 : 0);
#pragma unroll
        for (int ai = 0; ai < 2; ++ai)
#pragma unroll
            for (int m = 0; m < 4; ++m) { const int row = rowb + ai * 128 + wr * 64 + m * 16 + fr;
#pragma unroll
                for (int bj = 0; bj < 2; ++bj) *(v4u*)(Ob + (size_t)row * 1024 + colb + bj * 128 + wc * 32 + 8 * fq) = pack8(acc[ai][bj][m][0] * scale, acc[ai][bj][m][1] * scale); }
    }
};
struct EpiSoftmax {
    static constexpr bool PERM = true, AFTER_DRAIN = false;
    bf16* P; const float* ssq; LAS float* xch;
    __device__ __forceinline__ void operator()(const f32x4 (&acc_)[2][2][4][2], const pg8::Unit& u, int wr, int wc, int fr, int fq) const {
        f32x4 (&acc)[2][2][4][2] = const_cast<f32x4 (&)[2][2][4][2]>(acc_);
        const int row0 = u.pm * 256 + wr * 64 + fr, lrow0 = wr * 64 + fr;
#pragma unroll
        for (int ai = 0; ai < 2; ++ai)
#pragma unroll
            for (int m = 0; m < 4; ++m) { const float rs = row_rstd(ssq, row0 + ai * 128 + m * 16, fq); float mx = -3.0e38f;
#pragma unroll
                for (int bj = 0; bj < 2; ++bj)
#pragma unroll
                    for (int n = 0; n < 2; ++n) { const f32x4 a = acc[ai][bj][m][n]; mx = fmaxf(mx, fmaxf(fmaxf(a[0], a[1]), fmaxf(a[2], a[3]))); }
                mx *= rs; mx = fmaxf(mx, __shfl_xor(mx, 16)); mx = fmaxf(mx, __shfl_xor(mx, 32));
                if (fq == 0) xch[(lrow0 + ai * 128 + m * 16) * 4 + wc] = mx; }
        asm volatile("s_waitcnt lgkmcnt(0)" ::: "memory"); __builtin_amdgcn_s_barrier(); asm volatile("" ::: "memory");
#pragma unroll
        for (int ai = 0; ai < 2; ++ai)
#pragma unroll
            for (int m = 0; m < 4; ++m) { const f32x4 x4 = *(const LAS f32x4*)(xch + (lrow0 + ai * 128 + m * 16) * 4); const float mrow = fmaxf(fmaxf(x4[0], x4[1]), fmaxf(x4[2], x4[3])), rs = row_rstd(ssq, row0 + ai * 128 + m * 16, fq); float sm = 0.f;
#pragma unroll
                for (int bj = 0; bj < 2; ++bj)
#pragma unroll
                    for (int n = 0; n < 2; ++n) { f32x4 a = acc[ai][bj][m][n];
#pragma unroll
                        for (int i = 0; i < 4; ++i) { a[i] = __expf(a[i] * rs - mrow); sm += a[i]; }
                        asm volatile("" ::: "memory");
                        acc[ai][bj][m][n] = a; }
                sm += __shfl_xor(sm, 16); sm += __shfl_xor(sm, 32);
                if (fq == 0) xch[1024 + (lrow0 + ai * 128 + m * 16) * 4 + wc] = sm; }
        asm volatile("s_waitcnt lgkmcnt(0)" ::: "memory"); __builtin_amdgcn_s_barrier(); asm volatile("" ::: "memory");
#pragma unroll
        for (int ai = 0; ai < 2; ++ai)
#pragma unroll
            for (int m = 0; m < 4; ++m) { const f32x4 x4 = *(const LAS f32x4*)(xch + 1024 + (lrow0 + ai * 128 + m * 16) * 4); const float inv = __builtin_amdgcn_rcpf((x4[0] + x4[1]) + (x4[2] + x4[3]));
#pragma unroll
                for (int bj = 0; bj < 2; ++bj) *(v4u*)(P + (size_t)(row0 + ai * 128 + m * 16) * DM + u.pn * 256 + bj * 128 + wc * 32 + 8 * fq) = pack8(acc[ai][bj][m][0] * inv, acc[ai][bj][m][1] * inv); }
        asm volatile("s_waitcnt lgkmcnt(0)" ::: "memory"); __builtin_amdgcn_s_barrier(); asm volatile("" ::: "memory");
    }
};
struct Args { const float* in[23]; float* out; unsigned char* ws; };
struct Frame {
    LAS unsigned char* lds; int tid, lane, wave, vcu, G;
    float* out; unsigned char* ws;
};
#define LDS_WAIT() asm volatile("s_waitcnt lgkmcnt(0)" ::: "memory")

__device__ __forceinline__ void transpose_item(const float* W, int K, int N, bf16* WT, int rs, int off, const float* sc, LAS float* scr, int item, int nblk, int lane, int swp) {
    const int kb = item / nblk, nb = item % nblk, k0 = 64 * kb, n0 = 32 * nb;
    const int n = n0 + (lane & 31);
    float tv[32];
#pragma unroll
    for (int i = 0; i < 32; ++i) tv[i] = 0.f;
    if (n < N) { const float* p = W + (size_t)(k0 + (lane >> 5)) * N + n; int stepv = 2 * N; asm volatile("" : "+v"(stepv));
#pragma unroll
        for (int i = 0; i < 32; ++i) { tv[i] = *p; p += stepv; } }
#pragma unroll
    for (int i = 0; i < 32; ++i) scr[(2 * i + (lane >> 5)) * 33 + (lane & 31)] = tv[i];
    LDS_WAIT(); asm volatile("" ::: "memory");
    const int c = lane & 7;
    f32x4 s0 = {1.f, 1.f, 1.f, 1.f}, s1 = s0; if (sc) { s0 = *(const f32x4*)(sc + k0 + 8 * c); s1 = *(const f32x4*)(sc + k0 + 8 * c + 4); }
#pragma unroll
    for (int j = 0; j < 4; ++j) { const int nn = (lane >> 3) + 8 * j; const LAS float* s = scr + (8 * c) * 33 + nn;
        v4u o; o.x = cvt_pk_bf16(s[0 * 33] * s0[0], s[1 * 33] * s0[1]); o.y = cvt_pk_bf16(s[2 * 33] * s0[2], s[3 * 33] * s0[3]); o.z = cvt_pk_bf16(s[4 * 33] * s1[0], s[5 * 33] * s1[1]); o.w = cvt_pk_bf16(s[6 * 33] * s1[2], s[7 * 33] * s1[3]);
        const int ng = n0 + nn, t256 = ng >> 8, ts256 = (t256 == 3) ? 13 : (t256 == 13) ? 3 : (t256 == 2) ? 12 : (t256 == 12) ? 2 : t256, dr = swp ? ts256 * 256 + (ng & 255) : (ng / 128) * rs + off + (ng % 128);
        *(v4u*)(WT + (size_t)dr * K + k0 + 8 * c) = o; }
    LDS_WAIT(); asm volatile("" ::: "memory");
}
__device__ __forceinline__ void row_to_bf16(const float* xrow, bf16* orow, float* ssqrow, bool normalise, int lane) {
    const f32x4* xr = (const f32x4*)xrow + lane; f32x4 v[4]; float s = 0.f;
#pragma unroll
    for (int j = 0; j < 4; ++j) { v[j] = xr[64 * j]; s += (v[j][0] * v[j][0] + v[j][1] * v[j][1]) + (v[j][2] * v[j][2] + v[j][3] * v[j][3]); }
    s = wave_sum(s);
    const float rs = normalise ? 1.0f / sqrtf(s * (1.f / DM) + EPS) : 1.f;
    v2u* o8 = (v2u*)orow + lane;
#pragma unroll
    for (int j = 0; j < 4; ++j) { v2u w; w.x = cvt_pk_bf16(v[j][0] * rs, v[j][1] * rs); w.y = cvt_pk_bf16(v[j][2] * rs, v[j][3] * rs); o8[64 * j] = w; }
    if (ssqrow && lane < 16) ssqrow[lane] = (lane == 0) ? s : 0.f;
}
__device__ __forceinline__ void prologue(Frame& F, const Args& A, int l) {
    LAS float* scr = (LAS float*)(F.lds + F.wave * 16384);
    const int gw = F.vcu * NWAVES + F.wave, NGW = F.G * NWAVES;
    unsigned char* ws = F.ws;
    const size_t oFF = (size_t)l * DM * FFH, oDD = (size_t)l * DM * DM;
    constexpr int I_GU = 16 * 88, I_DN = 44 * 32, I_IN = 16 * 120, I_SQ = 16 * 32;
    constexpr int NITEMS = 6 * 1408 + I_IN + 4 * I_SQ;
    for (int it = gw; it < NITEMS; it += NGW) {
        int r = it, si, sci = -1, K = DM, N = FFH, rs = 128, off = 0, nblk = 32; size_t so = oFF, dsto;
        if (r < 6 * 1408) { const int w = r / 1408; r -= w * 1408; const int second = w >= 3, t = w % 3;
            if (t < 2) { si = (second ? 19 : 3) + t; sci = second ? 18 : 2; rs = 256; off = 128 * t; nblk = 88; dsto = second ? WS_W2A : WS_W1A; }
            else { si = second ? 21 : 5; K = FFH; N = DM; dsto = second ? WS_W2B : WS_W1B; } }
        else { r -= 6 * 1408;
            if (r < I_IN) { si = 7; sci = 6; N = NIN; nblk = 120; so = (size_t)l * DM * NIN; dsto = WS_WIN; }
            else { r -= I_IN; const int w = r / I_SQ; r -= w * I_SQ; N = DM; so = oDD;
                si = (w == 0) ? 11 : 14 + w; sci = (w == 1 || w == 2) ? 13 : -1;
                dsto = (w == 0) ? WS_WOUT : (w == 1) ? WS_WKV : (w == 2) ? WS_WKV + (size_t)DM * DM * 2 : WS_WO; } }
        transpose_item(A.in[si] + so, K, N, (bf16*)(ws + dsto), rs, off, sci >= 0 ? A.in[sci] + l * DM : nullptr, scr, r, nblk, F.lane, si == 7 ? 1 : 0);
    }
    for (int d = gw; d < DM; d += NGW) {
        const float sc = A.in[12][l * DM + d]; const f32x4* src = (const f32x4*)(A.in[14] + oDD + (size_t)d * DM) + F.lane; v2u* dst = (v2u*)((bf16*)(ws + WS_WQ) + (size_t)d * DM) + F.lane;
#pragma unroll
        for (int j = 0; j < 4; ++j) { const f32x4 v = src[64 * j] * sc; v2u w; w.x = cvt_pk_bf16(v[0], v[1]); w.y = cvt_pk_bf16(v[2], v[3]); dst[64 * j] = w; }
    }
    if (l == 0) {
        for (int m = gw; m < M; m += NGW) row_to_bf16(A.in[0] + (size_t)m * DM, (bf16*)(ws + WS_XB) + (size_t)m * DM, (float*)(ws + WS_SSQ) + (size_t)m * 16, false, F.lane);
        for (int m = gw; m < MROWS; m += NGW) row_to_bf16(A.in[1] + (size_t)m * DM, (bf16*)(ws + WS_MEMN) + (size_t)m * DM, nullptr, true, F.lane);
        for (int k = F.vcu * NTHREADS + F.tid; k < 512; k += F.G * NTHREADS) {
            float mx = -1e30f; for (int j = 0; j < DEPTH; ++j) mx = fmaxf(mx, A.in[8][j * 512 + k]);
            float den = 0.f; for (int j = 0; j < DEPTH; ++j) den += __expf(A.in[8][j * 512 + k] - mx);
            float cum = 0.f; for (int j = 0; j < DEPTH; ++j) { if (j > 0) cum += __expf(A.in[8][j * 512 + k] - mx) / den; ((float*)(ws + WS_LB))[j * 512 + k] = cum; }
        }
    }
}

__device__ __forceinline__ void fox_cumsum_unit(Frame& F, int bh) {
    const int b = bh >> 3, h = bh & 7; const float* FFp = (const float*)(F.ws + WS_FF); float* C2 = (float*)(F.ws + WS_C2);
    LAS float* wt = (LAS float*)F.lds;
    float v[16]; float run = 0.f;
#pragma unroll
    for (int i = 0; i < 16; ++i) v[i] = FFp[(size_t)(b * SEQ + F.tid * 16 + i) * 8 + h];
#pragma unroll
    for (int i = 0; i < 16; ++i) { run += v[i]; v[i] = run; }
    float inc = run;
#pragma unroll
    for (int o = 1; o < 64; o <<= 1) { const float t = __shfl_up(inc, o); if (F.lane >= o) inc += t; }
    if (F.lane == 63) wt[F.wave] = inc;
    __syncthreads();
    float base = inc - run;
    for (int w = 0; w < F.wave; ++w) base += wt[w];
#pragma unroll
    for (int i4 = 0; i4 < 4; ++i4) { f32x4 o4;
#pragma unroll
        for (int i = 0; i < 4; ++i) o4[i] = base + v[i4 * 4 + i];
        *(f32x4*)(C2 + (size_t)bh * SEQ + F.tid * 16 + i4 * 4) = o4; }
    __syncthreads();
}
constexpr size_t WS_KMAX = WS_LB + 8192, WS_QS = WS_LB + 16384, WS_ORD = WS_LB + 24576;
constexpr size_t WS_KMAX_ = 0;
__device__ __forceinline__ float sq8(const v4u w) { const float a0 = bflo(w.x), a1 = bfhi(w.x), a2 = bflo(w.y), a3 = bfhi(w.y), a4 = bflo(w.z), a5 = bfhi(w.z), a6 = bflo(w.w), a7 = bfhi(w.w); return (a0 * a0 + a1 * a1) + (a2 * a2 + a3 * a3) + (a4 * a4 + a5 * a5) + (a6 * a6 + a7 * a7); }
__device__ __forceinline__ float dot8(const v4u a, const v4u b) { return (bflo(a.x) * bflo(b.x) + bfhi(a.x) * bfhi(b.x)) + (bflo(a.y) * bflo(b.y) + bfhi(a.y) * bfhi(b.y)) + (bflo(a.z) * bflo(b.z) + bfhi(a.z) * bfhi(b.z)) + (bflo(a.w) * bflo(b.w) + bfhi(a.w) * bfhi(b.w)); }
__device__ __forceinline__ void fox_bounds(Frame& F) {
    const bf16* QO = (const bf16*)(F.ws + WS_QO); const bf16* FK = (const bf16*)(F.ws + WS_FK); const float* C2 = (const float*)(F.ws + WS_C2);
    float* KMAX = (float*)(F.ws + WS_KMAX); float* QS = (float*)(F.ws + WS_QS);
    if (F.wave < 4) return;
    const int gw = F.vcu * 4 + (F.wave - 4), NGW = F.G * 4;
    for (int item = gw; item < 2048 + 512; item += NGW) {
        if (item < 2048) { const int bh = item >> 7, t = item & 127, b = bh >> 3, h = bh & 7; const v4u* kp = (const v4u*)(FK + ((size_t)b * SEQ + t * 64 + F.lane) * 512 + h * 64);
            float k2 = 0.f;
#pragma unroll
            for (int d8 = 0; d8 < 8; ++d8) k2 += sq8(kp[d8]);
            k2 = wave_max(k2); if (F.lane == 0) KMAX[item] = sqrtf(k2);
        } else { const int it = item - 2048, bh = it >> 5, qb = it & 31, b = bh >> 3, h = bh & 7; float q2 = 0.f, sm = 3.0e38f;
#pragma unroll
            for (int r = 0; r < 4; ++r) { const int i = qb * 256 + F.lane + 64 * r; const size_t row = (size_t)b * SEQ + i;
                const v4u* qp = (const v4u*)(QO + row * DM + 512 + h * 64); const v4u* kp = (const v4u*)(FK + row * 512 + h * 64); float qq = 0.f, qk = 0.f;
#pragma unroll
                for (int d8 = 0; d8 < 8; ++d8) { const v4u qv = qp[d8]; qq += sq8(qv); qk += dot8(qv, kp[d8]); }
                q2 = fmaxf(q2, qq); sm = fminf(sm, qk - C2[(size_t)bh * SEQ + i]); }
            q2 = wave_max(q2); sm = -wave_max(-sm);
            if (F.lane == 0) { QS[it * 2] = sqrtf(q2); QS[it * 2 + 1] = sm; }
        }
    }
    if (F.wave == 4 && F.vcu < 256) {
        const int l16 = F.lane & 15; const float v = C2[(size_t)l16 * SEQ + SEQ - 1]; int rank = 0;
#pragma unroll
        for (int m = 0; m < 16; ++m) { const float vm = __shfl(v, m); rank += (vm < v || (vm == v && m < l16)) ? 1 : 0; }
        const int g = (F.vcu >> 4) & 15;
        const unsigned long long ma = __ballot(rank == g && F.lane < 16), mb = __ballot(rank == 15 - g && F.lane < 16);
        if (F.lane == 0) { int* ORD = (int*)(F.ws + WS_ORD); ORD[2 * F.vcu] = ma ? (int)__builtin_ctzll(ma) : g; ORD[2 * F.vcu + 1] = mb ? (int)__builtin_ctzll(mb) : 15 - g; }
    }
}
typedef short bf16x8_t __attribute__((ext_vector_type(8)));
__device__ __forceinline__ f32x4 mma16(bf16x8_t x, bf16x8_t y, f32x4 c) { return __builtin_amdgcn_mfma_f32_16x16x32_bf16(x, y, c, 0, 0, 0); }
constexpr int HG_LDK = 136, HG_LDS = 72;
constexpr int P1_QM = 0, P1_KM = 17408, P1_KLT = 34816, P1_VT = 53248, P1_AM = 71680, P1_TOT = 80896;
constexpr size_t WS_HD = 57 * MiB;
__device__ __forceinline__ void hgrn_pass1_unit(Frame& F, int unit) {
    const int bh = unit >> 7, c = unit & 127, b = bh >> 2, h = bh & 3; const size_t row0 = (size_t)b * SEQ + c * 64;
    float* LF = (float*)(F.ws + WS_LF); bf16* QO = (bf16*)(F.ws + WS_QO); const bf16* VH = (const bf16*)(F.ws + WS_VH);
    bf16* UT = (bf16*)F.out + (size_t)unit * 16384; float* HD = (float*)(F.ws + WS_HD) + (size_t)unit * 128;
    LAS bf16* Qm = (LAS bf16*)(F.lds + P1_QM); LAS bf16* Km = (LAS bf16*)(F.lds + P1_KM); LAS bf16* KlT = (LAS bf16*)(F.lds + P1_KLT); LAS bf16* VT = (LAS bf16*)(F.lds + P1_VT); LAS bf16* Am = (LAS bf16*)(F.lds + P1_AM);
    LAS float* tot = (LAS float*)(F.lds + P1_TOT);
    const int k = F.tid & 127, tq = F.tid >> 7, fr = F.lane & 15, fq = F.lane >> 4;
    float lf[16], g[16]; unsigned short qv[16], vv[16];
#pragma unroll
    for (int i = 0; i < 16; ++i) { const size_t r = row0 + 16 * tq + i; lf[i] = LF[r * 512 + h * 128 + k]; qv[i] = QO[r * DM + h * 128 + k]; vv[i] = VH[r * 512 + h * 128 + k]; }
    float run = 0.f;
#pragma unroll
    for (int i = 0; i < 16; ++i) { run += lf[i]; g[i] = run; }
    tot[tq * 128 + k] = run;
    { v4u w0, w1; w0.x = vv[0] | (vv[1] << 16); w0.y = vv[2] | (vv[3] << 16); w0.z = vv[4] | (vv[5] << 16); w0.w = vv[6] | (vv[7] << 16); w1.x = vv[8] | (vv[9] << 16); w1.y = vv[10] | (vv[11] << 16); w1.z = vv[12] | (vv[13] << 16); w1.w = vv[14] | (vv[15] << 16);
      *(LAS v4u*)(VT + k * HG_LDS + 16 * tq) = w0; *(LAS v4u*)(VT + k * HG_LDS + 16 * tq + 8) = w1; }
    __syncthreads();
    const float t0 = tot[k], t1 = tot[128 + k], t2 = tot[256 + k], t3 = tot[384 + k];
    const float off = (tq > 0 ? t0 : 0.f) + (tq > 1 ? t1 : 0.f) + (tq > 2 ? t2 : 0.f), gmid = t0 + t1, glast = gmid + t2 + t3;
    float kl[16];
#pragma unroll
    for (int i = 0; i < 16; ++i) { const size_t r = row0 + 16 * tq + i; const float gi = off + g[i], q = bf2f(qv[i]), kk = 1.f - __expf(lf[i]);
        QO[r * DM + h * 128 + k] = f2bf(q * __expf(gi));
        Qm[(16 * tq + i) * HG_LDK + k] = f2bf(q * __expf(fminf(gi - gmid, 80.f)));
        Km[(16 * tq + i) * HG_LDK + k] = f2bf(kk * __expf(fminf(gmid - gi, 80.f)));
        kl[i] = kk * __expf(glast - gi); }
    { v4u w0, w1; w0.x = cvt_pk_bf16(kl[0], kl[1]); w0.y = cvt_pk_bf16(kl[2], kl[3]); w0.z = cvt_pk_bf16(kl[4], kl[5]); w0.w = cvt_pk_bf16(kl[6], kl[7]); w1.x = cvt_pk_bf16(kl[8], kl[9]); w1.y = cvt_pk_bf16(kl[10], kl[11]); w1.z = cvt_pk_bf16(kl[12], kl[13]); w1.w = cvt_pk_bf16(kl[14], kl[15]);
      *(LAS v4u*)(KlT + k * HG_LDS + 16 * tq) = w0; *(LAS v4u*)(KlT + k * HG_LDS + 16 * tq + 8) = w1; }
    if (tq == 0) HD[k] = __expf(glast);
    __syncthreads();
#pragma unroll
    for (int it = 0; it < 2; ++it) { const int idx = F.wave + 8 * it, st = idx >> 2, tt = idx & 3; f32x4 a = {0.f, 0.f, 0.f, 0.f};
        if (st <= tt) {
#pragma unroll
            for (int kk = 0; kk < 4; ++kk) a = mma16(*(const LAS bf16x8_t*)(Km + (16 * st + fr) * HG_LDK + 8 * fq + 32 * kk), *(const LAS bf16x8_t*)(Qm + (16 * tt + fr) * HG_LDK + 8 * fq + 32 * kk), a);
        }
        const int s0 = 16 * st + 4 * fq, t = 16 * tt + fr;
#pragma unroll
        for (int j = 0; j < 4; ++j) a[j] = (s0 + j <= t) ? a[j] : 0.f;
        v2u w; w.x = cvt_pk_bf16(a[0], a[1]); w.y = cvt_pk_bf16(a[2], a[3]); *(LAS v2u*)(Am + t * HG_LDS + s0) = w; }
    { const bf16x8_t x0 = *(const LAS bf16x8_t*)(KlT + (16 * F.wave + fr) * HG_LDS + 8 * fq), x1 = *(const LAS bf16x8_t*)(KlT + (16 * F.wave + fr) * HG_LDS + 8 * fq + 32);
#pragma unroll
      for (int vt = 0; vt < 8; ++vt) { f32x4 a = {0.f, 0.f, 0.f, 0.f};
          a = mma16(x0, *(const LAS bf16x8_t*)(VT + (16 * vt + fr) * HG_LDS + 8 * fq), a); a = mma16(x1, *(const LAS bf16x8_t*)(VT + (16 * vt + fr) * HG_LDS + 8 * fq + 32), a);
          v2u w; w.x = cvt_pk_bf16(a[0], a[1]); w.y = cvt_pk_bf16(a[2], a[3]); *(v2u*)(UT + (16 * vt + fr) * 128 + 16 * F.wave + 4 * fq) = w; } }
    __syncthreads();
    { const bf16x8_t x0 = *(const LAS bf16x8_t*)(VT + (16 * F.wave + fr) * HG_LDS + 8 * fq), x1 = *(const LAS bf16x8_t*)(VT + (16 * F.wave + fr) * HG_LDS + 8 * fq + 32);
#pragma unroll
      for (int tt = 0; tt < 4; ++tt) { f32x4 a = {0.f, 0.f, 0.f, 0.f};
          a = mma16(x0, *(const LAS bf16x8_t*)(Am + (16 * tt + fr) * HG_LDS + 8 * fq), a); a = mma16(x1, *(const LAS bf16x8_t*)(Am + (16 * tt + fr) * HG_LDS + 8 * fq + 32), a);
          v2u w; w.x = cvt_pk_bf16(a[0], a[1]); w.y = cvt_pk_bf16(a[2], a[3]); *(v2u*)((bf16*)F.out + (size_t)16 * 1024 * 1024 + (row0 + 16 * tt + fr) * 512 + h * 128 + 16 * F.wave + 4 * fq) = w; } }
    __syncthreads();
}
__device__ __forceinline__ void hgrn_pass2(Frame& F) {
    if (F.tid >= 256) return;
    for (int item = F.vcu * 256 + F.tid; item < 8 * 128 * 64; item += F.G * 256) {
        const int bh = item >> 13, rem = item & 8191;
        unsigned* up = (unsigned*)((bf16*)F.out + (size_t)bh * 128 * 16384) + rem; const float2* dp = (const float2*)((const float*)(F.ws + WS_HD) + (size_t)bh * 128 * 128) + (rem & 63);
        float s0 = 0.f, s1 = 0.f;
#pragma unroll 32
        for (int c = 0; c < 128; ++c) { const unsigned u = up[(size_t)c * 8192]; const float2 d = dp[c * 64];
            up[(size_t)c * 8192] = cvt_pk_bf16(s0, s1);
            s0 = d.x * s0 + bflo(u); s1 = d.y * s1 + bfhi(u); }
    }
}
__device__ __forceinline__ void hgrn_pass3_unit(Frame& F, const float* onw, int pu) {
    const int unit0 = 2 * pu, fr = F.lane & 15, fq = F.lane >> 4;
    const bf16* UT = (const bf16*)F.out + (size_t)unit0 * 16384; const float* LF = (const float*)(F.ws + WS_LF); bf16* QO = (bf16*)(F.ws + WS_QO); const bf16* GH = (const bf16*)(F.ws + WS_GH);
#pragma unroll
    for (int i = 0; i < 8; ++i) { const int p = F.tid + 512 * i, cc = p >> 11, q = p & 2047, v = q >> 4, c8 = q & 15;
        *(LAS v4u*)(F.lds + cc * 34816 + v * 272 + c8 * 16) = *(const v4u*)(UT + (size_t)cc * 16384 + v * 128 + c8 * 8); }
    __syncthreads();
    const int cc = F.wave >> 2, tt = F.wave & 3, unit = unit0 + cc, bh = unit >> 7, c = unit & 127, b = bh >> 2, h = bh & 3;
    const size_t row = (size_t)b * SEQ + c * 64 + 16 * tt + fr;
    bf16x8_t yq[4];
#pragma unroll
    for (int kk = 0; kk < 4; ++kk) yq[kk] = *(const bf16x8_t*)(QO + row * DM + h * 128 + 8 * fq + 32 * kk);
    f32x4 o[8]; float ss = 0.f;
#pragma unroll
    for (int vt = 0; vt < 8; ++vt) { const v2u oi = *(const v2u*)((const bf16*)F.out + (size_t)16 * 1024 * 1024 + row * 512 + h * 128 + 16 * vt + 4 * fq); f32x4 a; a[0] = bflo(oi.x); a[1] = bfhi(oi.x); a[2] = bflo(oi.y); a[3] = bfhi(oi.y);
#pragma unroll
        for (int kk = 0; kk < 4; ++kk) a = mma16(*(const LAS bf16x8_t*)(F.lds + cc * 34816 + (16 * vt + fr) * 272 + (8 * fq + 32 * kk) * 2), yq[kk], a);
        o[vt] = a; ss += (a[0] * a[0] + a[1] * a[1]) + (a[2] * a[2] + a[3] * a[3]); }
    ss += __shfl_xor(ss, 16); ss += __shfl_xor(ss, 32);
    const float rs = __builtin_amdgcn_rsqf(ss * (1.f / 128.f) + EPS);
#pragma unroll
    for (int vt = 0; vt < 8; ++vt) { const int v0 = 16 * vt + 4 * fq; const f32x4 w4 = *(const f32x4*)(onw + v0); const v2u gt = *(const v2u*)(GH + row * 512 + h * 128 + v0);
        v2u w; w.x = cvt_pk_bf16(o[vt][0] * rs * w4[0] * bflo(gt.x), o[vt][1] * rs * w4[1] * bfhi(gt.x)); w.y = cvt_pk_bf16(o[vt][2] * rs * w4[2] * bflo(gt.y), o[vt][3] * rs * w4[3] * bfhi(gt.y));
        *(v2u*)(QO + row * DM + h * 128 + v0) = w; }
    __syncthreads();
}
__device__ __forceinline__ void final_norm(Frame& F, const float* w) {
    const int gw = F.vcu * NWAVES + F.wave, NGW = F.G * NWAVES; const float* ssq = (const float*)(F.ws + WS_SSQ); const bf16* XBp = (const bf16*)(F.ws + WS_XB);
    f32x4 wv[4];
#pragma unroll
    for (int j = 0; j < 4; ++j) wv[j] = ((const f32x4*)w + F.lane)[64 * j];
    for (int m = gw; m < M; m += 2 * NGW) {
        const int m1 = m + NGW; const bool two = m1 < M; const int mb = two ? m1 : m;
        float s0 = (F.lane < 16) ? ssq[(size_t)m * 16 + F.lane] : 0.f, s1 = (F.lane < 16) ? ssq[(size_t)mb * 16 + F.lane] : 0.f;
        const v2u* x0 = (const v2u*)(XBp + (size_t)m * DM) + F.lane; const v2u* x1 = (const v2u*)(XBp + (size_t)mb * DM) + F.lane;
        v2u b0[4], b1[4];
#pragma unroll
        for (int j = 0; j < 4; ++j) { b0[j] = x0[64 * j]; b1[j] = x1[64 * j]; }
        s0 = wave_sum(s0); s1 = wave_sum(s1);
        const float r0 = __builtin_amdgcn_rsqf(s0 * (1.f / DM) + EPS), r1 = __builtin_amdgcn_rsqf(s1 * (1.f / DM) + EPS);
        f32x4* o0 = (f32x4*)(F.out + (size_t)m * DM) + F.lane; f32x4* o1 = (f32x4*)(F.out + (size_t)mb * DM) + F.lane;
#pragma unroll
        for (int j = 0; j < 4; ++j) { f32x4 v; v[0] = bflo(b0[j].x); v[1] = bfhi(b0[j].x); v[2] = bflo(b0[j].y); v[3] = bfhi(b0[j].y); o0[64 * j] = v * r0 * wv[j]; }
        if (two) {
#pragma unroll
            for (int j = 0; j < 4; ++j) { f32x4 v; v[0] = bflo(b1[j].x); v[1] = bfhi(b1[j].x); v[2] = bflo(b1[j].y); v[3] = bfhi(b1[j].y); o1[64 * j] = v * r1 * wv[j]; } }
    }
}
#define RLX_AGENT __ATOMIC_RELAXED, __HIP_MEMORY_SCOPE_AGENT
#define XB_TMO      128
#define XB_XCNT(j)  (256  + 64 * (j))
#define XB_XSUB(j)  (1280 + 64 * (j))
#define XB_XGEN(j)  (2304 + 64 * (j))
#define XB_TOP      3328
#define XB_TOPGEN   3392
#define XB_SPIN_CAP (1u << 22)
__device__ __forceinline__ unsigned xb_ld_u(unsigned* p) { return (unsigned)__builtin_amdgcn_readfirstlane((int)__hip_atomic_load(p, RLX_AGENT)); }
__device__ __forceinline__ unsigned xb_add_u(unsigned* p, unsigned v, int lane) { unsigned r = 0u; if (lane == 0) r = __hip_atomic_fetch_add(p, v, RLX_AGENT); return (unsigned)__builtin_amdgcn_readfirstlane((int)r); }
__device__ __forceinline__ unsigned xb_xcc_id() { return (unsigned)__builtin_amdgcn_s_getreg((3 << 11) | 20) & 0xFu; }
#define XB_SPIN_U(cond, bar) do { unsigned _sp = 0; while (cond) { __builtin_amdgcn_s_sleep(1); if (++_sp > XB_SPIN_CAP) { if (lane == 0) atomicAdd(&(bar)[XB_TMO], 1u); break; } } } while (0)
__device__ __forceinline__ void xcd_barrier(unsigned* bar, volatile __attribute__((address_space(3))) unsigned* st, int wave, int lane) {
    asm volatile("s_waitcnt vmcnt(0)" ::: "memory");
    __syncthreads();
    if (wave == 0) {
        __builtin_amdgcn_s_waitcnt(0);
        const unsigned x = xb_xcc_id();
        unsigned nloc = (unsigned)__builtin_amdgcn_readfirstlane((int)st[0]), nx = (unsigned)__builtin_amdgcn_readfirstlane((int)st[1]);
        if (nloc == 0u) {
            const unsigned G = gridDim.x; unsigned sp = 0u;
            (void)xb_add_u(&bar[XB_XCNT(x)], 1u, lane);
            for (;;) { unsigned sum = 0u, cnt = 0u, mine = 0u;
#pragma unroll
                for (unsigned j = 0; j < 16; ++j) { const unsigned c = xb_ld_u(&bar[XB_XCNT(j)]); sum += c; cnt += (c > 0u) ? 1u : 0u; mine = (j == x) ? c : mine; }
                nloc = mine > 0u ? mine : 1u; nx = cnt > 0u ? cnt : 1u;
                if (sum == G) break;
                __builtin_amdgcn_s_sleep(1);
                if (++sp > XB_SPIN_CAP) { if (lane == 0) atomicAdd(&bar[XB_TMO], 1u); break; } }
            if (lane == 0) { st[0] = nloc; st[1] = nx; }
        }
        const unsigned old = xb_add_u(&bar[XB_XSUB(x)], 1u, lane), gen = old / nloc;
        if (old + 1u == (gen + 1u) * nloc) {
            __builtin_amdgcn_fence(__ATOMIC_RELEASE, "agent");
            asm volatile("s_waitcnt vmcnt(0)" ::: "memory");
            const unsigned og = xb_add_u(&bar[XB_TOP], 1u, lane), tg = og / nx;
            if (og + 1u == (tg + 1u) * nx) (void)xb_add_u(&bar[XB_TOPGEN], 1u, lane);
            else XB_SPIN_U(xb_ld_u(&bar[XB_TOPGEN]) == tg, bar);
            __builtin_amdgcn_fence(__ATOMIC_ACQUIRE, "agent");
            (void)xb_add_u(&bar[XB_XGEN(x)], 1u, lane);
            asm volatile("s_waitcnt vmcnt(0)" ::: "memory");
        } else {
            XB_SPIN_U(xb_ld_u(&bar[XB_XGEN(x)]) == gen, bar);
            __builtin_amdgcn_fence(__ATOMIC_ACQUIRE, "agent");
            asm volatile("s_waitcnt vmcnt(0)" ::: "memory");
        }
    }
    __syncthreads();
}

constexpr size_t WS_CTL = 226 * MiB, CTL_BYTES = 65536, WS_END3 = 227 * MiB;
constexpr int LDS_MISC = 139264;
template <class T> __device__ __forceinline__ T* uni_ptr(T* p) { const unsigned long long v = (unsigned long long)p; const unsigned lo = __builtin_amdgcn_readfirstlane((unsigned)v), hi = __builtin_amdgcn_readfirstlane((unsigned)(v >> 32)); return (T*)(((unsigned long long)hi << 32) | lo); }
__global__ void __launch_bounds__(NTHREADS, 2) mega_fwd(Args args) {
    extern __shared__ __attribute__((aligned(16))) unsigned char lds[];
    cg::grid_group grid = cg::this_grid();
    #define PHASE_PTRS int bx_ = blockIdx.x; asm volatile("" : "+s"(bx_)); int G_ = gridDim.x; asm volatile("" : "+s"(G_)); (void)bx_; (void)G_; LAS unsigned char* ldsp = (LAS unsigned char*)lds; asm volatile("" : "+s"(ldsp)); (void)ldsp; unsigned char* ws = args.ws; asm volatile("" : "+s"(ws)); float* outp = args.out; asm volatile("" : "+s"(outp)); bf16* XB = (bf16*)(ws + WS_XB); float* SSQ = (float*)(ws + WS_SSQ); bf16* ACT = (bf16*)(ws + WS_ACT); (void)XB; (void)SSQ; (void)ACT; (void)outp;
#define MKFRAME Frame F; { int t_ = threadIdx.x; asm volatile("" : "+v"(t_)); F.lds = ldsp; F.tid = t_; F.lane = t_ & 63; F.wave = __builtin_amdgcn_readfirstlane(t_ >> 6); F.G = G_; F.vcu = (G_ % 8 == 0) ? (bx_ % 8) * (G_ / 8) + bx_ / 8 : bx_; F.ws = ws; F.out = outp; }
#define GSYNC() do { LAS unsigned char* l_ = (LAS unsigned char*)lds; asm volatile("" : "+s"(l_)); unsigned char* w_ = args.ws; asm volatile("" : "+s"(w_)); int t_ = threadIdx.x; asm volatile("" : "+v"(t_)); xcd_barrier((unsigned*)(w_ + WS_CTL), (volatile LAS unsigned*)(l_ + LDS_MISC), __builtin_amdgcn_readfirstlane(t_ >> 6), t_ & 63); } while (0)
    if (threadIdx.x < 16) ((volatile LAS unsigned*)((LAS unsigned char*)lds + LDS_MISC))[threadIdx.x] = 0u;
    __syncthreads();
    for (int l = 0; l < DEPTH; ++l) {
#ifndef NO_PRO
        { PHASE_PTRS MKFRAME
        prologue(F, args, l); }
#endif
        if (gridDim.y > 1) grid.sync(); else GSYNC();
        {   PHASE_PTRS
            pg8::Gemm g{XB, (const bf16*)(ws + WS_W1A), M, 2 * FFH, DM, DM, DM}; pg8::StaticOrder S; S.init(M, 2 * FFH, G_, bx_);
            EpiSwiglu E{ACT, SSQ};
            pg8::gemm_phase<EpiSwiglu, pg8::StaticOrder, true, true>(ldsp, g, S, E);
            pg8::Gemm g2{(const bf16*)(ws + WS_MEMN), (const bf16*)(ws + WS_WKV), MROWS, 2 * DM, DM, DM, DM}; pg8::StaticOrder S2; S2.init(MROWS, 2 * DM, G_, bx_ >= 128 ? bx_ - 128 : (1 << 28));
            EpiPlain E2{(bf16*)(ws + WS_KV), 2 * DM, nullptr, 1.f};
            pg8::gemm_phase<EpiPlain, pg8::StaticOrder, true, true>(ldsp, g2, S2, E2);
        }
        GSYNC();
        {   PHASE_PTRS
            pg8::Gemm g{ACT, (const bf16*)(ws + WS_W1B), M, DM, FFH, FFH, FFH}; pg8::StaticOrder S; S.init(M, DM, G_, bx_);
            EpiRes E{XB, SSQ, 0.5f};
            pg8::gemm_phase<EpiRes, pg8::StaticOrder, true, true>(ldsp, g, S, E);
        }
        GSYNC();
        {   PHASE_PTRS
            pg8::Gemm g{XB, (const bf16*)(ws + WS_WIN), M, NINP, DM, DM, DM}; pg8::StaticOrder S; S.init(M, NINP, G_, bx_);
            EpiWin E{ws, (const float*)(ws + WS_LB) + l * 512, args.in[10] + l * 8};
            pg8::gemm_phase<EpiWin, pg8::StaticOrder, true, true>(ldsp, g, S, E);
        }
        {   PHASE_PTRS
            int kf_ = 256; asm volatile("" : "+s"(kf_));
            { pg8::Gemm gA{(const bf16*)(ws + WS_KV), (const bf16*)(ws + WS_WQ), 256, 256, kf_, 2 * DM, DM}; pg8::FoldOrder SA{bx_ - 192, false}; EpiFold EA{(bf16*)(ws + WS_WQK), false, 0.0625f};
              pg8::gemm_phase<EpiFold, pg8::FoldOrder, true, true>(ldsp, gA, SA, EA); }
            { pg8::Gemm gB{(const bf16*)(ws + WS_WO), (const bf16*)(ws + WS_KV), 256, 256, kf_, DM, 2 * DM}; pg8::FoldOrder SB{bx_ - 224, true}; EpiFold EB{(bf16*)(ws + WS_VWO), true, 1.f};
              pg8::gemm_phase<EpiFold, pg8::FoldOrder, true, true>(ldsp, gB, SB, EB); }
        }
        GSYNC();
        { PHASE_PTRS MKFRAME
          for (int u = F.vcu; u < 1024 + 16; u += F.G) { if (u < 1024) hgrn_pass1_unit(F, u); else fox_cumsum_unit(F, u - 1024); } }
        GSYNC();
        { PHASE_PTRS MKFRAME fox_bounds(F); hgrn_pass2(F); }
        GSYNC();
        { PHASE_PTRS MKFRAME for (int u = F.vcu; u < 512; u += F.G) hgrn_pass3_unit(F, args.in[9] + l * 128, u); }
        {   PHASE_PTRS
            const attn_body::AttnTensors AT{(const attn_body::bf16*)(ws + WS_QO) + 512, (const attn_body::bf16*)(ws + WS_FK), (const attn_body::bf16*)(ws + WS_FV), (attn_body::bf16*)(ws + WS_QO) + 512, (const float*)(ws + WS_C2), (const float*)(ws + WS_KMAX), (const float*)(ws + WS_QS)};
            const attn_body::StaticOrder S(G_, bx_, (const int*)(ws + WS_ORD));
            attn_body::attn_phase<attn_body::StaticOrder>((char*)ldsp, AT, S);
        }
        GSYNC();
        {   PHASE_PTRS
            pg8::Gemm g{(const bf16*)(ws + WS_QO), (const bf16*)(ws + WS_WOUT), M, DM, DM, DM, DM}; pg8::StaticOrder S; S.init(M, DM, G_, bx_);
            EpiRes E{XB, SSQ, 1.0f};
            pg8::gemm_phase<EpiRes, pg8::StaticOrder, true, true>(ldsp, g, S, E);
        }
        GSYNC();
        {   PHASE_PTRS
            pg8::Gemm g{XB, (const bf16*)(ws + WS_WQK), M, DM, DM, DM, DM}; pg8::BatchOrder S; S.init(M, DM, G_, bx_); S.mb = SEQ / 256; S.bstride = (size_t)DM * DM * 2;
            EpiSoftmax E{(bf16*)(ws + WS_PB), SSQ, (LAS float*)(ldsp + 131072)};
            pg8::gemm_phase<EpiSoftmax, pg8::BatchOrder, true, true>(ldsp, g, S, E);
        }
        GSYNC();
        {   PHASE_PTRS
            pg8::Gemm g{(const bf16*)(ws + WS_PB), (const bf16*)(ws + WS_VWO), M, DM, DM, DM, DM}; pg8::BatchOrder S; S.init(M, DM, G_, bx_); S.mb = SEQ / 256; S.bstride = (size_t)DM * DM * 2;
            EpiRes E{XB, SSQ, 1.0f};
            pg8::gemm_phase<EpiRes, pg8::BatchOrder, true, true>(ldsp, g, S, E);
        }
        GSYNC();
        {   PHASE_PTRS
            pg8::Gemm g{XB, (const bf16*)(ws + WS_W2A), M, 2 * FFH, DM, DM, DM}; pg8::StaticOrder S; S.init(M, 2 * FFH, G_, bx_);
            EpiSwiglu E{ACT, SSQ};
            pg8::gemm_phase<EpiSwiglu, pg8::StaticOrder, true, true>(ldsp, g, S, E);
        }
        GSYNC();
        {   PHASE_PTRS
            pg8::Gemm g{ACT, (const bf16*)(ws + WS_W2B), M, DM, FFH, FFH, FFH}; pg8::StaticOrder S; S.init(M, DM, G_, bx_);
            EpiRes E{XB, SSQ, 0.5f};
            pg8::gemm_phase<EpiRes, pg8::StaticOrder, true, true>(ldsp, g, S, E);
        }
        GSYNC();
    }
    { PHASE_PTRS MKFRAME
    final_norm(F, args.in[22]); }
}

extern "C" void kernel_launch(void* const* d_in, const int* in_sizes, int n_in, void* d_out, int out_size, void* d_ws, size_t ws_size, hipStream_t stream) {
    static int grid = 0;
    if (grid == 0) {
        if (n_in != 23 || out_size != M * DM || ws_size < WS_END3) { fprintf(stderr, "kernel_launch: unexpected shapes n_in %d out %d ws %zu\n", n_in, out_size, ws_size); grid = -1; return; }
        int dev = 0, cus = 0, per_cu = 0;
        hipGetDevice(&dev); hipDeviceGetAttribute(&cus, hipDeviceAttributeMultiprocessorCount, dev);
        hipFuncSetAttribute((const void*)mega_fwd, hipFuncAttributeMaxDynamicSharedMemorySize, LDS_BYTES);
        hipOccupancyMaxActiveBlocksPerMultiprocessor(&per_cu, (const void*)mega_fwd, NTHREADS, LDS_BYTES);
        (void)hipGetLastError();
        if (per_cu < 1) per_cu = 1;
        grid = cus;
    }
    if (grid < 0) return;
    if (hipMemsetAsync((char*)d_ws + WS_CTL, 0, CTL_BYTES, stream) != hipSuccess) { fprintf(stderr, "kernel_launch: memset of the barrier words failed\n"); return; }
    Args a{};
    for (int i = 0; i < 23; ++i) a.in[i] = (const float*)d_in[i];
    a.out = (float*)d_out; a.ws = (unsigned char*)d_ws;
    void* kargs[] = {&a};
    hipError_t e = hipLaunchCooperativeKernel((const void*)mega_fwd, dim3(grid), dim3(NTHREADS), kargs, LDS_BYTES, stream);
    if (e != hipSuccess) fprintf(stderr, "cooperative launch failed: %s (grid %d)\n", hipGetErrorString(e), grid);
}
```
